# Optimizing an MI355X kernel written in HIP

```python
import math
import jax, jax.numpy as jnp
from jax import lax
import numpy as np

D_MODEL = 1024
BATCH = 8
SEQ = 4096
DEPTH = 1

CHUNK = 64
Q_BLOCK = 128
HEAD_DIM = 64
N_HEADS_FOX = D_MODEL // (2 * HEAD_DIM)
N_HEADS_DIFF = D_MODEL // (2 * HEAD_DIM)
FOX_WIDTH = N_HEADS_FOX * HEAD_DIM
DIFF_WIDTH = N_HEADS_DIFF * HEAD_DIM
MIX_WIDTH = FOX_WIDTH + DIFF_WIDTH
DIFF_HALF = HEAD_DIM // 2
IN_PROJ_WIDTH = 3 * FOX_WIDTH + N_HEADS_FOX + 3 * DIFF_WIDTH
REL_BUCKETS = 32
REL_MAX_DIST = 128
PLE_DIM = 256
PEER_HEADS = 8
PEER_N_KEYS = 128
PEER_N_EXPERTS = PEER_N_KEYS * PEER_N_KEYS
PEER_KEY_DIM = 256
PEER_TOPK = 16
PEER_TOKEN_BLOCK = 128
EPS = 1e-6
NEG_INF = -1e30

kernel_name = "fox_diffattn_peer_hybrid_layer"


def rms_norm(x, g):
    x32 = x.astype(jnp.float32)
    y = x32 * lax.rsqrt(jnp.mean(x32 * x32, axis=-1, keepdims=True) + EPS)
    return (y * g.astype(jnp.float32)).astype(x.dtype)


def t5_bucket(rel):
    half = REL_BUCKETS // 2
    max_exact = half // 2
    ret = jnp.where(rel > 0, half, 0)
    n = jnp.abs(rel)
    nf = jnp.maximum(n, 1).astype(jnp.float32)
    large = max_exact + (jnp.log(nf / max_exact) / math.log(REL_MAX_DIST / max_exact)
                         * (half - max_exact)).astype(jnp.int32)
    large = jnp.minimum(large, half - 1)
    return ret + jnp.where(n < max_exact, n, large)


def hybrid_mixer(n, w_in, b_f, fox_q_gain, fox_k_gain, diff_q_gain, diff_k_gain,
                 lambda_q1, lambda_k1, lambda_q2, lambda_k2, diff_sub_gain,
                 rel_bias_table, w_out, lambda_init):
    B, S, _ = n.shape
    f32 = jnp.float32
    proj = n @ w_in
    splits = [FOX_WIDTH, 2 * FOX_WIDTH, 3 * FOX_WIDTH, 3 * FOX_WIDTH + N_HEADS_FOX,
              3 * FOX_WIDTH + N_HEADS_FOX + DIFF_WIDTH,
              3 * FOX_WIDTH + N_HEADS_FOX + 2 * DIFF_WIDTH]
    qf, kf, vf, f_logit, qd, kd, vd = jnp.split(proj, splits, axis=-1)

    def heads(a, h, d):
        return a.reshape(B, S, h, d).transpose(0, 2, 1, 3)

    qf = rms_norm(heads(qf, N_HEADS_FOX, HEAD_DIM), fox_q_gain).astype(f32)
    kf = rms_norm(heads(kf, N_HEADS_FOX, HEAD_DIM), fox_k_gain).astype(f32)
    vf = heads(vf, N_HEADS_FOX, HEAD_DIM)
    log_f = jax.nn.log_sigmoid(f_logit.astype(f32) + b_f.astype(f32))
    cf = lax.cumsum(log_f, axis=1).transpose(0, 2, 1)

    def halves(a, g):
        a = a.reshape(B, S, N_HEADS_DIFF, 2, DIFF_HALF).transpose(0, 2, 3, 1, 4)
        return rms_norm(a, g).astype(f32)
    qd = halves(qd, diff_q_gain)
    kd = halves(kd, diff_k_gain)
    qd1, qd2 = qd[:, :, 0], qd[:, :, 1]
    kd1, kd2 = kd[:, :, 0], kd[:, :, 1]
    vd = heads(vd, N_HEADS_DIFF, HEAD_DIM)
    lam = (jnp.exp(jnp.sum(lambda_q1.astype(f32) * lambda_k1.astype(f32)))
           - jnp.exp(jnp.sum(lambda_q2.astype(f32) * lambda_k2.astype(f32)))
           + lambda_init)

    fox_scale = HEAD_DIM ** -0.5
    diff_scale = DIFF_HALF ** -0.5
    key_pos = jnp.arange(S)
    n_blocks = S // Q_BLOCK

    def block(i):
        q0 = i * Q_BLOCK
        qpos = q0 + jnp.arange(Q_BLOCK)
        take = lambda a: lax.dynamic_slice_in_dim(a, q0, Q_BLOCK, axis=2)
        logit = (jnp.einsum('bhqd,bhkd->bhqk', take(qf), kf) * fox_scale
                 + take(cf)[..., None] - cf[:, :, None, :])
        frame_causal = key_pos[None, :] <= qpos[:, None]
        p_f = jax.nn.softmax(jnp.where(frame_causal, logit, NEG_INF), axis=-1)
        o_f = jnp.einsum('bhqk,bhkd->bhqd', p_f.astype(vf.dtype), vf)
        bias = rel_bias_table[t5_bucket(key_pos[None, :] - qpos[:, None])]
        bias = bias.astype(f32).transpose(2, 0, 1)
        chunk_causal = (key_pos // CHUNK)[None, :] <= (qpos // CHUNK)[:, None]

        def smap(q, k):
            l = jnp.einsum('bhqd,bhkd->bhqk', q, k) * diff_scale + bias
            return jax.nn.softmax(jnp.where(chunk_causal, l, NEG_INF), axis=-1)
        a = smap(take(qd1), kd1) - lam * smap(take(qd2), kd2)
        o_d = jnp.einsum('bhqk,bhkd->bhqd', a.astype(vd.dtype), vd)
        return o_f, o_d

    o_f, o_d = lax.map(block, jnp.arange(n_blocks))
    o_f = o_f.transpose(1, 0, 3, 2, 4).reshape(B, S, FOX_WIDTH)
    o_d = o_d.transpose(1, 0, 3, 2, 4).reshape(B, S, N_HEADS_DIFF, HEAD_DIM)
    o_d = (rms_norm(o_d, diff_sub_gain) * (1.0 - lambda_init)).reshape(B, S, DIFF_WIDTH)
    return jnp.concatenate([o_f, o_d], axis=-1) @ w_out


def peer(n, w_query, sub_keys, expert_in, expert_out):
    B, S, D = n.shape
    f32 = jnp.float32
    xt = n.reshape((B * S) // PEER_TOKEN_BLOCK, PEER_TOKEN_BLOCK, D)

    def block(xb):
        q = (xb @ w_query).reshape(PEER_TOKEN_BLOCK, PEER_HEADS, 2, PEER_KEY_DIM // 2).astype(f32)
        s = jnp.einsum('thcd,hckd->thck', q, sub_keys.astype(f32))
        top_s, top_i = lax.top_k(s, PEER_TOPK)
        cand_s = (top_s[:, :, 0, :, None] + top_s[:, :, 1, None, :]).reshape(
            PEER_TOKEN_BLOCK, PEER_HEADS, PEER_TOPK * PEER_TOPK)
        cand_i = (top_i[:, :, 0, :, None] * PEER_N_KEYS + top_i[:, :, 1, None, :]).reshape(
            PEER_TOKEN_BLOCK, PEER_HEADS, PEER_TOPK * PEER_TOPK)
        best_s, pos = lax.top_k(cand_s, PEER_TOPK)
        idx = jnp.take_along_axis(cand_i, pos, axis=-1)
        g = jax.nn.softmax(best_s, axis=-1)
        u = expert_in[idx]
        act = jax.nn.gelu(jnp.einsum('td,thkd->thk', xb, u).astype(f32), approximate=False) * g
        return jnp.einsum('thk,thkd->td', act.astype(xb.dtype), expert_out[idx])

    return lax.map(block, xt).reshape(B, S, D)


def setup_inputs(seed: int = 0) -> dict:
    key = jax.random.key(seed)
    ks = jax.random.split(key, 32)
    nrm = lambda k, shape, scale: jax.random.normal(k, shape, jnp.float32) * scale
    gain = lambda k, shape: 1.0 + 0.1 * jax.random.normal(k, shape, jnp.float32)
    return {
        "x": nrm(ks[0], (BATCH, SEQ, D_MODEL), 1.0),
        "p": nrm(ks[1], (DEPTH, BATCH, SEQ, PLE_DIM), 1.0),
        "mix_norm": gain(ks[2], (DEPTH, D_MODEL)),
        "w_in": nrm(ks[3], (DEPTH, D_MODEL, IN_PROJ_WIDTH), D_MODEL ** -0.5),
        "b_f": 3.0 + 0.5 * jax.random.normal(ks[4], (DEPTH, N_HEADS_FOX), jnp.float32),
        "fox_q_gain": gain(ks[5], (DEPTH, HEAD_DIM)),
        "fox_k_gain": gain(ks[6], (DEPTH, HEAD_DIM)),
        "diff_q_gain": gain(ks[7], (DEPTH, DIFF_HALF)),
        "diff_k_gain": gain(ks[8], (DEPTH, DIFF_HALF)),
        "lambda_q1": nrm(ks[9], (DEPTH, DIFF_HALF), 0.1),
        "lambda_k1": nrm(ks[10], (DEPTH, DIFF_HALF), 0.1),
        "lambda_q2": nrm(ks[11], (DEPTH, DIFF_HALF), 0.1),
        "lambda_k2": nrm(ks[12], (DEPTH, DIFF_HALF), 0.1),
        "diff_sub_gain": gain(ks[13], (DEPTH, HEAD_DIM)),
        "rel_bias_table": nrm(ks[14], (REL_BUCKETS, N_HEADS_DIFF), 0.5),
        "w_out": nrm(ks[15], (DEPTH, MIX_WIDTH, D_MODEL), MIX_WIDTH ** -0.5),
        "peer_norm": gain(ks[16], (DEPTH, D_MODEL)),
        "peer_w_query": nrm(ks[17], (DEPTH, D_MODEL, PEER_HEADS * PEER_KEY_DIM), D_MODEL ** -0.5),
        "peer_sub_keys": nrm(ks[18], (DEPTH, PEER_HEADS, 2, PEER_N_KEYS, PEER_KEY_DIM // 2),
                             (PEER_KEY_DIM // 2) ** -0.5),
        "peer_expert_in": nrm(ks[19], (DEPTH, PEER_N_EXPERTS, D_MODEL), D_MODEL ** -0.5),
        "peer_expert_out": nrm(ks[20], (DEPTH, PEER_N_EXPERTS, D_MODEL), 0.5),
        "ple_norm": gain(ks[21], (DEPTH, D_MODEL)),
        "ple_w_gate": nrm(ks[22], (DEPTH, D_MODEL, D_MODEL), D_MODEL ** -0.5),
        "ple_w_proj": nrm(ks[23], (DEPTH, PLE_DIM, D_MODEL), PLE_DIM ** -0.5),
    }


def reference(x, p, mix_norm, w_in, b_f, fox_q_gain, fox_k_gain, diff_q_gain, diff_k_gain,
              lambda_q1, lambda_k1, lambda_q2, lambda_k2, diff_sub_gain, rel_bias_table,
              w_out, peer_norm, peer_w_query, peer_sub_keys, peer_expert_in, peer_expert_out,
              ple_norm, ple_w_gate, ple_w_proj):
    h = x
    for i in range(DEPTH):
        lambda_init = 0.8 - 0.6 * math.exp(-0.3 * i)
        h = h + hybrid_mixer(rms_norm(h, mix_norm[i]), w_in[i], b_f[i], fox_q_gain[i],
                             fox_k_gain[i], diff_q_gain[i], diff_k_gain[i], lambda_q1[i],
                             lambda_k1[i], lambda_q2[i], lambda_k2[i], diff_sub_gain[i],
                             rel_bias_table, w_out[i], lambda_init)
        h = h + peer(rms_norm(h, peer_norm[i]), peer_w_query[i], peer_sub_keys[i],
                     peer_expert_in[i], peer_expert_out[i])
        gate = jax.nn.sigmoid((rms_norm(h, ple_norm[i]) @ ple_w_gate[i]).astype(jnp.float32))
        h = h + gate.astype(h.dtype) * (p[i] @ ple_w_proj[i])
    return h
```

```cpp
#include <hip/hip_runtime.h>
#include <cstdio>
#include <cstdint>
#include <cmath>
namespace pg8 {
#define PG8_LAS __attribute__((address_space(3)))
typedef unsigned short bf16_t;
typedef short bf16x8 __attribute__((ext_vector_type(8)));
typedef float f32x4 __attribute__((ext_vector_type(4)));
typedef unsigned u32x4 __attribute__((ext_vector_type(4)));
constexpr int BM = 256, BK = 64, HALF = 128, HTB = HALF * BK * 2  , STAGE_BYTES = 8 * HTB, NXCD = 8, WGM = 8;

__host__ __device__ __forceinline__ int lds_byte(int r, int c) { const int st = (r >> 4) * 2 + (c >> 5), rr = r & 15, cc = c & 31, ob = rr * 64 + cc * 2; return st * 1024 + (ob ^ (((ob >> 9) & 1) << 5)); }
__host__ __device__ __forceinline__ void stage_rc(int b, int& R, int& C) { const int st = b / 1024, sb = b % 1024, swz = sb ^ (((sb >> 9) & 1) << 5); R = (st >> 1) * 16 + swz / 64; C = (st & 1) * 32 + (swz % 64) / 2; }
__host__ __device__ __forceinline__ int perm32(int rho) { const int n = rho >> 4, i = rho & 15; return 8 * (i >> 2) + 4 * n + (i & 3); }

struct Unit { int pm, pn; };
struct Gemm { const bf16_t* A; const bf16_t* Bt; int M, N, K, pad; };

struct StaticOrder {
    int nM, nN, nwg, G, c;
    __host__ __device__ void init(int M, int N, int G_, int c_) { nM = M / BM; nN = N / BM; nwg = nM * nN; G = G_; c = c_; }
    __host__ __device__ bool next(int i, Unit& u) const {
        const long L = (long)i * G + c; if (L >= nwg) return false;
        int wgid = (int)L; { const int q = nwg / NXCD, r = nwg % NXCD, xcd = wgid % NXCD, off = wgid / NXCD; wgid = (xcd < r ? xcd * (q + 1) : r * (q + 1) + (xcd - r) * q) + off; }
        const int nig = WGM * nN, gid = wgid / nig, fm = gid * WGM, gsz = (nM - fm) < WGM ? (nM - fm) : WGM;
        u.pm = fm + ((wgid % nig) % gsz); u.pn = (wgid % nig) / gsz; return true;
    }
    __device__ __forceinline__ void a_ready(const Unit&) const {}
    __device__ __forceinline__ void done(const Unit&) const {}
};

__device__ __forceinline__ unsigned cvt_pk_bf16(float lo, float hi) { unsigned r; asm volatile("v_cvt_pk_bf16_f32 %0, %1, %2" : "=v"(r) : "v"(lo), "v"(hi)); return r; }
typedef float f32x2 __attribute__((ext_vector_type(2)));
struct EpiBf16P {
    static constexpr bool PERM = true, AFTER_DRAIN = false;
    bf16_t* O; int ldc, pad;
    __device__ __forceinline__ void operator()(const f32x4 (&acc)[2][2][4][2], const Unit& u, int wr, int wc, int fr, int fq) const {
        const int row0 = u.pm * BM + wr * 64 + fr; const int col0 = u.pn * BM + wc * 32 + 8 * fq;
#pragma unroll
        for (int ai = 0; ai < 2; ++ai)
#pragma unroll
            for (int m = 0; m < 4; ++m) { bf16_t* rowp = O + (size_t)(row0 + ai * HALF + m * 16) * ldc + col0;
#pragma unroll
                for (int bj = 0; bj < 2; ++bj) { const f32x4 v0 = acc[ai][bj][m][0], v1 = acc[ai][bj][m][1];
                    u32x4 w; w.x = cvt_pk_bf16(v0[0], v0[1]); w.y = cvt_pk_bf16(v0[2], v0[3]); w.z = cvt_pk_bf16(v1[0], v1[1]); w.w = cvt_pk_bf16(v1[2], v1[3]);
                    *(u32x4*)(rowp + bj * HALF) = w; } }
    }
};
struct EpiF32 {
    static constexpr bool PERM = false, AFTER_DRAIN = false;
    const float* base; float* out; int ldc, pad;
    __device__ __forceinline__ void operator()(const f32x4 (&acc)[2][2][4][2], const Unit& u, int wr, int wc, int fr, int fq) const {
        const int col0 = u.pn * BM + wc * 32 + 4 * fq;
#pragma unroll
        for (int ai = 0; ai < 2; ++ai)
#pragma unroll
            for (int m = 0; m < 4; ++m) { const size_t off = (size_t)(u.pm * BM + ai * HALF + wr * 64 + m * 16 + fr) * ldc + col0;
#pragma unroll
                for (int bj = 0; bj < 2; ++bj)
#pragma unroll
                    for (int n = 0; n < 2; ++n) { f32x4 o = acc[ai][bj][m][n]; if (base) o += *(const f32x4*)(base + off + bj * HALF + n * 16); *(f32x4*)(out + off + bj * HALF + n * 16) = o; } }
    }
};
template <class Epi, class Sched, bool ALIGN_EPI = false, bool SP2 = false>
__device__ __forceinline__ void gemm_phase(PG8_LAS unsigned char* lds, const Gemm g, const Sched& S, const Epi& E) {
    const int tid = threadIdx.x, wid = __builtin_amdgcn_readfirstlane(tid >> 6), lane = tid & 63, wr = wid >> 2, wc = wid & 3, fr = lane & 15, fq = lane >> 4;
    const int K = g.K, nt = K / BK;
    unsigned voffA[2], voffB[2];
#pragma unroll
    for (int i = 0; i < 2; ++i) { int R, C; stage_rc(tid * 16 + i * 8192, R, C); const int Rb = Epi::PERM ? ((R & ~31) + perm32(R & 31)) : R;
        voffA[i] = (unsigned)(R * K + C) * 2u; voffB[i] = (unsigned)(Rb * K + C) * 2u; }
    const size_t kstep = (size_t)(BK * 2);
    const size_t hstep = (size_t)HALF * K * 2;
    const size_t tstep = 2 * hstep;
    const unsigned ldsw = (unsigned)wid * 1024u;
    const int aoff = lds_byte(wr * 64 + fr, fq * 8), boff = lds_byte(wc * 32 + fr, fq * 8);
#define PG8_SA(b, h) (((b) * 2 + (h)) * HTB)
#define PG8_SB(b, h) ((4 + (b) * 2 + (h)) * HTB)
#define PG8_STAGE(bufoff, gbase, voff) do { _Pragma("unroll") for (int _i = 0; _i < 2; ++_i) \
        __builtin_amdgcn_global_load_lds((const unsigned*)((const char*)(gbase) + (voff)[_i]), (PG8_LAS unsigned*)(lds + (bufoff) + ldsw + _i * 8192), 16, 0, 0); } while (0)
#define PG8_LDA(dst, b, h) do { _Pragma("unroll") for (int m = 0; m < 4; ++m) _Pragma("unroll") for (int k = 0; k < 2; ++k) dst[m][k] = *(const PG8_LAS bf16x8*)(lds + PG8_SA(b, h) + aoff + m * 2048 + k * 1024); } while (0)
#define PG8_LDB(dst, b, h) do { _Pragma("unroll") for (int n = 0; n < 2; ++n) _Pragma("unroll") for (int k = 0; k < 2; ++k) dst[n][k] = *(const PG8_LAS bf16x8*)(lds + PG8_SB(b, h) + boff + n * 2048 + k * 1024); } while (0)
#define PG8_MMA(ai, bj, At, Bt) do { __builtin_amdgcn_s_setprio(1); _Pragma("unroll") for (int m = 0; m < 4; ++m) _Pragma("unroll") for (int n = 0; n < 2; ++n) _Pragma("unroll") for (int k = 0; k < 2; ++k) \
        acc[ai][bj][m][n] = __builtin_amdgcn_mfma_f32_16x16x32_bf16(Bt[n][k], At[m][k], acc[ai][bj][m][n], 0, 0, 0); __builtin_amdgcn_s_setprio(0); } while (0)
#define PG8_WAIT_V(n) asm volatile("s_waitcnt vmcnt(" #n ")" ::: "memory")
#define PG8_WAIT_L(n) asm volatile("s_waitcnt lgkmcnt(" #n ")" ::: "memory")
#define PG8_BAR __builtin_amdgcn_s_barrier()
#define PG8_SCHED __builtin_amdgcn_sched_barrier(0)
    Unit cur, nxt; int ui = 0;
    if (!S.next(0, cur)) return;
    f32x4 acc[2][2][4][2];
#pragma unroll
    for (int a = 0; a < 2; ++a)
#pragma unroll
        for (int b = 0; b < 2; ++b)
#pragma unroll
            for (int m = 0; m < 4; ++m)
#pragma unroll
                for (int n = 0; n < 2; ++n) acc[a][b][m][n] = (f32x4){0.f, 0.f, 0.f, 0.f};
    bf16x8 At[4][2], B0[2][2], B1[2][2];
    const char* cA = (const char*)g.A + (size_t)cur.pm * tstep; const char* cB = (const char*)g.Bt + (size_t)cur.pn * tstep;
    S.a_ready(cur);
    if constexpr (SP2) {
        PG8_STAGE(PG8_SB(0, 0), cB, voffB); PG8_STAGE(PG8_SB(0, 1), cB + hstep, voffB); PG8_STAGE(PG8_SA(0, 0), cA, voffA); PG8_STAGE(PG8_SA(0, 1), cA + hstep, voffA);
        if (wr == 1) PG8_BAR;
        PG8_WAIT_V(2); PG8_BAR;
        PG8_STAGE(PG8_SB(1, 0), cB + kstep, voffB); PG8_STAGE(PG8_SA(1, 0), cA + kstep, voffA); PG8_STAGE(PG8_SB(1, 1), cB + hstep + kstep, voffB);
        PG8_WAIT_V(6); PG8_BAR;
    } else {
        PG8_STAGE(PG8_SB(0, 0), cB, voffB); PG8_STAGE(PG8_SA(0, 0), cA, voffA); PG8_STAGE(PG8_SB(0, 1), cB + hstep, voffB); PG8_STAGE(PG8_SA(0, 1), cA + hstep, voffA);
        if (wr == 1) PG8_BAR;
        PG8_WAIT_V(4); PG8_BAR;
        PG8_STAGE(PG8_SB(1, 0), cB + kstep, voffB); PG8_STAGE(PG8_SA(1, 0), cA + kstep, voffA); PG8_STAGE(PG8_SB(1, 1), cB + hstep + kstep, voffB);
        PG8_WAIT_V(6); PG8_BAR;
    }
    for (;;) {
        const bool has_next = S.next(ui + 1, nxt);
        const char* nA = has_next ? (const char*)g.A + (size_t)nxt.pm * tstep : cA; const char* nB = has_next ? (const char*)g.Bt + (size_t)nxt.pn * tstep : cB;
        for (int t = 0; t < nt; t += 2) {
            const bool last = (t == nt - 2);
            const char* a1 = cA + (size_t)(t + 1) * kstep;
            const char* a2 = last ? nA : cA + (size_t)(t + 2) * kstep; const char* b2 = last ? nB : cB + (size_t)(t + 2) * kstep;
            const char* a3 = a2 + kstep; const char* b3 = b2 + kstep;
            if (last && has_next) S.a_ready(nxt);
            if constexpr (SP2) {
            PG8_LDB(B0, 0, 0); PG8_LDB(B1, 0, 1); PG8_SCHED; PG8_LDA(At, 0, 0); PG8_STAGE(PG8_SA(1, 1), a1 + hstep, voffA);
            PG8_WAIT_V(8); PG8_WAIT_L(0); PG8_BAR; PG8_MMA(0, 0, At, B0); PG8_MMA(0, 1, At, B1); PG8_BAR; PG8_SCHED;
            PG8_LDA(At, 0, 1); PG8_STAGE(PG8_SB(0, 0), b2, voffB); PG8_STAGE(PG8_SB(0, 1), b2 + hstep, voffB); PG8_STAGE(PG8_SA(0, 0), a2, voffA);
            PG8_WAIT_V(8); PG8_WAIT_L(0); PG8_BAR; PG8_MMA(1, 0, At, B0); PG8_MMA(1, 1, At, B1); PG8_BAR; PG8_SCHED;
            PG8_LDB(B0, 1, 0); PG8_LDB(B1, 1, 1); PG8_SCHED; PG8_LDA(At, 1, 0); PG8_STAGE(PG8_SA(0, 1), a2 + hstep, voffA);
            PG8_WAIT_V(8); PG8_WAIT_L(0); PG8_BAR; PG8_MMA(0, 0, At, B0); PG8_MMA(0, 1, At, B1); PG8_BAR; PG8_SCHED;
            PG8_LDA(At, 1, 1); PG8_STAGE(PG8_SB(1, 0), b3, voffB); PG8_STAGE(PG8_SB(1, 1), b3 + hstep, voffB); PG8_STAGE(PG8_SA(1, 0), a3, voffA);
            PG8_WAIT_V(8); PG8_WAIT_L(0); PG8_BAR; PG8_MMA(1, 0, At, B0); PG8_MMA(1, 1, At, B1); PG8_BAR; PG8_SCHED;
            } else {
            PG8_LDB(B0, 0, 0); PG8_SCHED; PG8_LDA(At, 0, 0); PG8_STAGE(PG8_SA(1, 1), a1 + hstep, voffA);
            PG8_WAIT_L(8); PG8_BAR; PG8_WAIT_L(0); PG8_MMA(0, 0, At, B0); PG8_BAR; PG8_SCHED;
            PG8_LDB(B1, 0, 1); PG8_STAGE(PG8_SB(0, 0), b2, voffB);
            PG8_BAR; PG8_WAIT_L(0); PG8_MMA(0, 1, At, B1); PG8_BAR;
            PG8_LDA(At, 0, 1); PG8_STAGE(PG8_SA(0, 0), a2, voffA);
            PG8_BAR; PG8_WAIT_L(0); PG8_MMA(1, 0, At, B0); PG8_BAR; PG8_SCHED;
            PG8_STAGE(PG8_SB(0, 1), b2 + hstep, voffB);
            PG8_WAIT_V(6); PG8_BAR; PG8_MMA(1, 1, At, B1); PG8_BAR;
            PG8_LDB(B0, 1, 0); PG8_SCHED; PG8_LDA(At, 1, 0); PG8_STAGE(PG8_SA(0, 1), a2 + hstep, voffA);
            PG8_WAIT_L(8); PG8_BAR; PG8_WAIT_L(0); PG8_MMA(0, 0, At, B0); PG8_BAR; PG8_SCHED;
            PG8_LDB(B1, 1, 1); PG8_STAGE(PG8_SB(1, 0), b3, voffB);
            PG8_BAR; PG8_WAIT_L(0); PG8_MMA(0, 1, At, B1); PG8_BAR;
            PG8_LDA(At, 1, 1); PG8_STAGE(PG8_SA(1, 0), a3, voffA);
            PG8_BAR; PG8_WAIT_L(0); PG8_MMA(1, 0, At, B0); PG8_BAR; PG8_SCHED;
            PG8_STAGE(PG8_SB(1, 1), b3 + hstep, voffB);
            PG8_WAIT_V(6); PG8_BAR; PG8_MMA(1, 1, At, B1); PG8_BAR;
            }
        }
        if constexpr (ALIGN_EPI) { if (wr == 0) PG8_BAR; }
        if constexpr (!Epi::AFTER_DRAIN) { E(acc, cur, wr, wc, fr, fq); S.done(cur); }
        if (!has_next) break;
#pragma unroll
        for (int a = 0; a < 2; ++a)
#pragma unroll
            for (int b = 0; b < 2; ++b)
#pragma unroll
                for (int m = 0; m < 4; ++m)
#pragma unroll
                    for (int n = 0; n < 2; ++n) acc[a][b][m][n] = (f32x4){0.f, 0.f, 0.f, 0.f};
        cur = nxt; cA = nA; cB = nB; ++ui;
        if constexpr (ALIGN_EPI) { if (wr == 1) PG8_BAR; }
    }
    PG8_WAIT_V(0);
    if constexpr (!ALIGN_EPI) { if (wr == 0) PG8_BAR; }
    PG8_BAR;
    if constexpr (Epi::AFTER_DRAIN) { E.fused(acc, cur, wr, wc, fr, fq, lds, wid, lane); S.done(cur); }
#undef PG8_SA
#undef PG8_SB
#undef PG8_STAGE
#undef PG8_LDA
#undef PG8_LDB
#undef PG8_MMA
#undef PG8_WAIT_V
#undef PG8_WAIT_L
#undef PG8_BAR
#undef PG8_SCHED
}
}

constexpr int NB = 8, SEQ = 4096, DM = 1024, TOK = NB * SEQ, NPROJ = 3080, NPROJ_PAD = 3328;
constexpr int OFF_QF = 0, OFF_KF = 512, OFF_VF = 1024, OFF_FL = 1536, OFF_QD = 1544, OFF_KD = 2056, OFF_VD = 2568;
constexpr float EPS = 1e-6f;
constexpr size_t MiB = 1u << 20;
constexpr size_t WS_WT_IN = 0, WS_WT_OUT = 7 * MiB, WS_WT_Q = 9 * MiB, WS_WT_GATE = 13 * MiB, WS_WT_PLE = 15 * MiB, WS_XN = 16 * MiB,
                 WS_PROJ = 80 * MiB, WS_O = 80 * MiB, WS_GATE = 80 * MiB, WS_QKV = 288 * MiB, WS_Q = 288 * MiB, WS_PLE = 288 * MiB, WS_PBF = 416 * MiB,
                 WS_IDX = 480 * MiB, WS_G = 496 * MiB, WS_END = 512 * MiB;
constexpr size_t QKV_SEC = (size_t)NB * 8 * SEQ * 64;

typedef unsigned short bf16;
#define LAS __attribute__((address_space(3)))
__device__ __forceinline__ unsigned f2bf(float f) { unsigned u = __builtin_bit_cast(unsigned, f); return (u + 0x7fffu + ((u >> 16) & 1u)) >> 16; }
__device__ __forceinline__ float bf2f(unsigned short u) { return __builtin_bit_cast(float, (unsigned)u << 16); }
__device__ __forceinline__ float wave_sum(float v) {
#pragma unroll
    for (int o = 1; o < 64; o <<= 1) v += __shfl_xor(v, o);
    return v;
}

template <class Epi> __global__ void __launch_bounds__(512, 2) k_gemm(pg8::Gemm g, Epi E) {
    extern __shared__ __attribute__((aligned(16))) unsigned char lds[];
    pg8::StaticOrder S; S.init(g.M, g.N, (int)gridDim.x, (int)blockIdx.x);
    pg8::gemm_phase<Epi, pg8::StaticOrder, true, true>((PG8_LAS unsigned char*)lds, g, S, E);
}

__global__ void k_transpose(const float* __restrict__ W, int K, int N, bf16* __restrict__ WT) {
    __shared__ float t[32][33];
    const int n0 = blockIdx.x * 32, k0 = blockIdx.y * 32, tx = threadIdx.x, ty = threadIdx.y;
#pragma unroll
    for (int j = 0; j < 4; ++j) { const int k = k0 + ty + 8 * j, n = n0 + tx; t[ty + 8 * j][tx] = (n < N) ? W[(size_t)k * N + n] : 0.f; }
    __syncthreads();
#pragma unroll
    for (int j = 0; j < 4; ++j) { const int n = n0 + ty + 8 * j, k = k0 + tx; WT[(size_t)n * K + k] = (bf16)f2bf(t[tx][ty + 8 * j]); }
}
__global__ void k_cvt_bf16(const float* __restrict__ in, bf16* __restrict__ out, size_t n) {
    for (size_t i = (size_t)blockIdx.x * blockDim.x + threadIdx.x; i < n; i += (size_t)gridDim.x * blockDim.x) out[i] = (bf16)f2bf(in[i]);
}
__global__ void __launch_bounds__(256) k_rmsnorm(const float* __restrict__ X, const float* __restrict__ g, bf16* __restrict__ out, int rows) {
    const int lane = threadIdx.x & 63, row = blockIdx.x * 4 + (threadIdx.x >> 6); if (row >= rows) return;
    const float4* xr = (const float4*)(X + (size_t)row * DM) + lane; float4 v[4]; float ss = 0.f;
#pragma unroll
    for (int j = 0; j < 4; ++j) { v[j] = xr[64 * j]; ss += v[j].x * v[j].x + v[j].y * v[j].y + v[j].z * v[j].z + v[j].w * v[j].w; }
    const float r = rsqrtf(wave_sum(ss) * (1.f / DM) + EPS);
#pragma unroll
    for (int j = 0; j < 4; ++j) { const float4 gg = ((const float4*)g)[lane + 64 * j]; const size_t o = (size_t)row * DM + 4 * (lane + 64 * j);
        out[o] = (bf16)f2bf(v[j].x * r * gg.x); out[o + 1] = (bf16)f2bf(v[j].y * r * gg.y); out[o + 2] = (bf16)f2bf(v[j].z * r * gg.z); out[o + 3] = (bf16)f2bf(v[j].w * r * gg.w); }
}
__device__ __forceinline__ float log_sigmoid(float z) { return fminf(z, 0.f) - log1pf(expf(-fabsf(z))); }

__global__ void __launch_bounds__(256) k_qkvprep(const bf16* __restrict__ proj, bf16* __restrict__ qkv, float* __restrict__ logf, const float* __restrict__ b_f,
                                                  const float* __restrict__ gfq, const float* __restrict__ gfk, const float* __restrict__ gdq, const float* __restrict__ gdk) {
    const int gid = blockIdx.x * 256 + threadIdx.x, tok = gid >> 4, hs = gid & 15, b = tok >> 12, s = tok & 4095;
    const bf16* pr = proj + (size_t)tok * NPROJ_PAD;
    if (hs < 8) { const int h = hs; const size_t o = ((size_t)(b * 8 + h) * SEQ + s) * 64;
        float sq = 0.f, sk = 0.f;
        for (int d = 0; d < 64; ++d) { const float q = bf2f(pr[OFF_QF + h * 64 + d]), k = bf2f(pr[OFF_KF + h * 64 + d]); sq += q * q; sk += k * k; }
        const float rq = rsqrtf(sq * (1.f / 64) + EPS), rk = rsqrtf(sk * (1.f / 64) + EPS);
        for (int d = 0; d < 64; ++d) { qkv[0 * QKV_SEC + o + d] = (bf16)f2bf(bf2f(pr[OFF_QF + h * 64 + d]) * rq * gfq[d]); qkv[1 * QKV_SEC + o + d] = (bf16)f2bf(bf2f(pr[OFF_KF + h * 64 + d]) * rk * gfk[d]);
            qkv[2 * QKV_SEC + o + d] = pr[OFF_VF + h * 64 + d]; }
        logf[(size_t)(b * 8 + h) * SEQ + s] = log_sigmoid(bf2f(pr[OFF_FL + h]) + b_f[h]);
    } else { const int h = hs - 8; const size_t o = ((size_t)(b * 8 + h) * SEQ + s) * 64;
        for (int c = 0; c < 2; ++c) { float sq = 0.f, sk = 0.f;
            for (int d = 0; d < 32; ++d) { const float q = bf2f(pr[OFF_QD + h * 64 + c * 32 + d]), k = bf2f(pr[OFF_KD + h * 64 + c * 32 + d]); sq += q * q; sk += k * k; }
            const float rq = rsqrtf(sq * (1.f / 32) + EPS), rk = rsqrtf(sk * (1.f / 32) + EPS);
            for (int d = 0; d < 32; ++d) { qkv[3 * QKV_SEC + o + c * 32 + d] = (bf16)f2bf(bf2f(pr[OFF_QD + h * 64 + c * 32 + d]) * rq * gdq[d]);
                qkv[4 * QKV_SEC + o + c * 32 + d] = (bf16)f2bf(bf2f(pr[OFF_KD + h * 64 + c * 32 + d]) * rk * gdk[d]); } }
        for (int d = 0; d < 64; ++d) qkv[5 * QKV_SEC + o + d] = pr[OFF_VD + h * 64 + d];
    }
}
__global__ void k_cumsum(float* __restrict__ c) {
    const int bh = threadIdx.x; float a = 0.f; float* p = c + (size_t)bh * SEQ;
    for (int s = 0; s < SEQ; ++s) { a += p[s]; p[s] = a; }
}

__global__ void __launch_bounds__(256) k_fox(const bf16* __restrict__ qkv, const float* __restrict__ C, bf16* __restrict__ O) {
    const int bh = blockIdx.y, t = blockIdx.x * 256 + threadIdx.x, b = bh >> 3, h = bh & 7;
    const bf16* Q = qkv + 0 * QKV_SEC + ((size_t)bh * SEQ) * 64; const bf16* K = qkv + 1 * QKV_SEC + ((size_t)bh * SEQ) * 64; const bf16* V = qkv + 2 * QKV_SEC + ((size_t)bh * SEQ) * 64;
    const float* Cb = C + (size_t)bh * SEQ;
    float q[64], o[64];
#pragma unroll
    for (int d = 0; d < 64; ++d) { q[d] = bf2f(Q[(size_t)t * 64 + d]) * 0.125f; o[d] = 0.f; }
    float m = -INFINITY, l = 0.f; const float ct = Cb[t];
    const int tmax = (blockIdx.x * 256 + (threadIdx.x | 63));
    for (int s = 0; s <= tmax; ++s) {
        const uint4* kr = (const uint4*)(K + (size_t)s * 64); float dot = 0.f;
#pragma unroll
        for (int c = 0; c < 8; ++c) { const uint4 w = kr[c];
            dot += q[8 * c + 0] * __builtin_bit_cast(float, w.x << 16) + q[8 * c + 1] * __builtin_bit_cast(float, w.x & 0xffff0000u) + q[8 * c + 2] * __builtin_bit_cast(float, w.y << 16) + q[8 * c + 3] * __builtin_bit_cast(float, w.y & 0xffff0000u)
                 + q[8 * c + 4] * __builtin_bit_cast(float, w.z << 16) + q[8 * c + 5] * __builtin_bit_cast(float, w.z & 0xffff0000u) + q[8 * c + 6] * __builtin_bit_cast(float, w.w << 16) + q[8 * c + 7] * __builtin_bit_cast(float, w.w & 0xffff0000u); }
        float logit = dot + ct - Cb[s]; if (s > t) logit = -INFINITY;
        const float mn = fmaxf(m, logit), al = __expf(m - mn), p = __expf(logit - mn); m = mn; l = l * al + p;
        const uint4* vr = (const uint4*)(V + (size_t)s * 64);
#pragma unroll
        for (int c = 0; c < 8; ++c) { const uint4 w = vr[c];
            o[8 * c + 0] = o[8 * c + 0] * al + p * __builtin_bit_cast(float, w.x << 16); o[8 * c + 1] = o[8 * c + 1] * al + p * __builtin_bit_cast(float, w.x & 0xffff0000u);
            o[8 * c + 2] = o[8 * c + 2] * al + p * __builtin_bit_cast(float, w.y << 16); o[8 * c + 3] = o[8 * c + 3] * al + p * __builtin_bit_cast(float, w.y & 0xffff0000u);
            o[8 * c + 4] = o[8 * c + 4] * al + p * __builtin_bit_cast(float, w.z << 16); o[8 * c + 5] = o[8 * c + 5] * al + p * __builtin_bit_cast(float, w.z & 0xffff0000u);
            o[8 * c + 6] = o[8 * c + 6] * al + p * __builtin_bit_cast(float, w.w << 16); o[8 * c + 7] = o[8 * c + 7] * al + p * __builtin_bit_cast(float, w.w & 0xffff0000u); }
    }
    const float il = 1.f / l; bf16* orow = O + ((size_t)b * SEQ + t) * DM + h * 64;
#pragma unroll
    for (int d = 0; d < 64; ++d) orow[d] = (bf16)f2bf(o[d] * il);
}
__device__ __forceinline__ int t5_bucket(int rel) {
    const int ret = rel > 0 ? 16 : 0; const int n = rel < 0 ? -rel : rel; const float nf = (float)(n < 1 ? 1 : n);
    int large = 8 + (int)(logf(nf / 8.f) / 2.772588722239781f * 8.f); large = large < 15 ? large : 15;
    return ret + (n < 8 ? n : large);
}
__global__ void __launch_bounds__(256) k_diff(const bf16* __restrict__ qkv, const float* __restrict__ table, const float* __restrict__ lq1, const float* __restrict__ lk1,
                                               const float* __restrict__ lq2, const float* __restrict__ lk2, const float* __restrict__ gsub, bf16* __restrict__ O) {
    const int bh = blockIdx.y, t = blockIdx.x * 256 + threadIdx.x, b = bh >> 3, h = bh & 7;
    const bf16* Q = qkv + 3 * QKV_SEC + ((size_t)bh * SEQ) * 64; const bf16* K = qkv + 4 * QKV_SEC + ((size_t)bh * SEQ) * 64; const bf16* V = qkv + 5 * QKV_SEC + ((size_t)bh * SEQ) * 64;
    float q[64], o1[64], o2[64];
    const float sc = 0.17677669529663687f;
#pragma unroll
    for (int d = 0; d < 64; ++d) { q[d] = bf2f(Q[(size_t)t * 64 + d]) * sc; o1[d] = 0.f; o2[d] = 0.f; }
    float m1 = -INFINITY, l1 = 0.f, m2 = -INFINITY, l2 = 0.f;
    const int send = 64 * (t / 64 + 1);
    for (int s = 0; s < send; ++s) {
        const uint4* kr = (const uint4*)(K + (size_t)s * 64); float d1 = 0.f, d2 = 0.f;
#pragma unroll
        for (int c = 0; c < 4; ++c) { const uint4 w = kr[c];
            d1 += q[8 * c + 0] * __builtin_bit_cast(float, w.x << 16) + q[8 * c + 1] * __builtin_bit_cast(float, w.x & 0xffff0000u) + q[8 * c + 2] * __builtin_bit_cast(float, w.y << 16) + q[8 * c + 3] * __builtin_bit_cast(float, w.y & 0xffff0000u)
                + q[8 * c + 4] * __builtin_bit_cast(float, w.z << 16) + q[8 * c + 5] * __builtin_bit_cast(float, w.z & 0xffff0000u) + q[8 * c + 6] * __builtin_bit_cast(float, w.w << 16) + q[8 * c + 7] * __builtin_bit_cast(float, w.w & 0xffff0000u); }
#pragma unroll
        for (int c = 4; c < 8; ++c) { const uint4 w = kr[c];
            d2 += q[8 * c + 0] * __builtin_bit_cast(float, w.x << 16) + q[8 * c + 1] * __builtin_bit_cast(float, w.x & 0xffff0000u) + q[8 * c + 2] * __builtin_bit_cast(float, w.y << 16) + q[8 * c + 3] * __builtin_bit_cast(float, w.y & 0xffff0000u)
                + q[8 * c + 4] * __builtin_bit_cast(float, w.z << 16) + q[8 * c + 5] * __builtin_bit_cast(float, w.z & 0xffff0000u) + q[8 * c + 6] * __builtin_bit_cast(float, w.w << 16) + q[8 * c + 7] * __builtin_bit_cast(float, w.w & 0xffff0000u); }
        const float bias = table[t5_bucket(s - t) * 8 + h];
        const float g1 = d1 + bias, g2 = d2 + bias;
        const float mn1 = fmaxf(m1, g1), a1 = __expf(m1 - mn1), p1 = __expf(g1 - mn1); m1 = mn1; l1 = l1 * a1 + p1;
        const float mn2 = fmaxf(m2, g2), a2 = __expf(m2 - mn2), p2 = __expf(g2 - mn2); m2 = mn2; l2 = l2 * a2 + p2;
        const uint4* vr = (const uint4*)(V + (size_t)s * 64);
#pragma unroll
        for (int c = 0; c < 8; ++c) { const uint4 w = vr[c]; float v[8];
            v[0] = __builtin_bit_cast(float, w.x << 16); v[1] = __builtin_bit_cast(float, w.x & 0xffff0000u); v[2] = __builtin_bit_cast(float, w.y << 16); v[3] = __builtin_bit_cast(float, w.y & 0xffff0000u);
            v[4] = __builtin_bit_cast(float, w.z << 16); v[5] = __builtin_bit_cast(float, w.z & 0xffff0000u); v[6] = __builtin_bit_cast(float, w.w << 16); v[7] = __builtin_bit_cast(float, w.w & 0xffff0000u);
#pragma unroll
            for (int e = 0; e < 8; ++e) { o1[8 * c + e] = o1[8 * c + e] * a1 + p1 * v[e]; o2[8 * c + e] = o2[8 * c + e] * a2 + p2 * v[e]; } }
    }
    float s1 = 0.f, s2 = 0.f;
    for (int i = 0; i < 32; ++i) { s1 += lq1[i] * lk1[i]; s2 += lq2[i] * lk2[i]; }
    const float lam = expf(s1) - expf(s2) + 0.2f;
    const float i1 = 1.f / l1, i2 = lam / l2; float ss = 0.f;
#pragma unroll
    for (int d = 0; d < 64; ++d) { o1[d] = o1[d] * i1 - o2[d] * i2; ss += o1[d] * o1[d]; }
    const float r = rsqrtf(ss * (1.f / 64) + EPS) * 0.8f; bf16* orow = O + ((size_t)b * SEQ + t) * DM + 512 + h * 64;
#pragma unroll
    for (int d = 0; d < 64; ++d) orow[d] = (bf16)f2bf(o1[d] * r * gsub[d]);
}

__global__ void __launch_bounds__(256) k_topk(const bf16* __restrict__ q, const float* __restrict__ SK, int* __restrict__ idx, float* __restrict__ gw) {
    const int lane = threadIdx.x & 63, wu = blockIdx.x * 4 + (threadIdx.x >> 6), tok = wu >> 3, h = wu & 7;
    const bf16* qr = q + (size_t)tok * 2048 + h * 256;
    float sc[2][2];
#pragma unroll
    for (int c = 0; c < 2; ++c)
#pragma unroll
        for (int j = 0; j < 2; ++j) { const float* kr = SK + (((size_t)(h * 2 + c) * 128) + lane + 64 * j) * 128; float a = 0.f;
            for (int d = 0; d < 128; ++d) a += bf2f(qr[c * 128 + d]) * kr[d];
            sc[c][j] = a; }
    float ts[2] = {0.f, 0.f}; int ti[2] = {0, 0};
#pragma unroll
    for (int c = 0; c < 2; ++c)
        for (int k = 0; k < 16; ++k) {
            float bv = sc[c][0]; int bi = lane; if (sc[c][1] > bv) { bv = sc[c][1]; bi = lane + 64; }
#pragma unroll
            for (int o = 1; o < 64; o <<= 1) { const float ov = __shfl_xor(bv, o); const int oi = __shfl_xor(bi, o); if (ov > bv || (ov == bv && oi < bi)) { bv = ov; bi = oi; } }
            if (lane == k) { ts[c] = bv; ti[c] = bi; }
            if (bi == lane) sc[c][0] = -INFINITY; if (bi == lane + 64) sc[c][1] = -INFINITY;
        }
    float cs[4]; int ci[4];
#pragma unroll
    for (int j = 0; j < 4; ++j) { const int cnd = lane + 64 * j, a = cnd >> 4, bb = cnd & 15;
        cs[j] = __shfl(ts[0], a) + __shfl(ts[1], bb); ci[j] = __shfl(ti[0], a) * 128 + __shfl(ti[1], bb); }
    float bs = 0.f; int be = 0;
    for (int k = 0; k < 16; ++k) {
        float bv = cs[0]; int bp = lane; int bidx = ci[0];
#pragma unroll
        for (int j = 1; j < 4; ++j) if (cs[j] > bv) { bv = cs[j]; bp = lane + 64 * j; bidx = ci[j]; }
#pragma unroll
        for (int o = 1; o < 64; o <<= 1) { const float ov = __shfl_xor(bv, o); const int op = __shfl_xor(bp, o); const int oi = __shfl_xor(bidx, o); if (ov > bv || (ov == bv && op < bp)) { bv = ov; bp = op; bidx = oi; } }
        if (lane == k) { bs = bv; be = bidx; }
#pragma unroll
        for (int j = 0; j < 4; ++j) if (bp == lane + 64 * j) cs[j] = -INFINITY;
    }
    const float mx = __shfl(bs, 0); float e = lane < 16 ? __expf(bs - mx) : 0.f; float sum = e;
#pragma unroll
    for (int o = 1; o < 16; o <<= 1) sum += __shfl_xor(sum, o);
    if (lane < 16) { idx[(size_t)tok * 128 + h * 16 + lane] = be; gw[(size_t)tok * 128 + h * 16 + lane] = e / sum; }
}
__device__ __forceinline__ float gelu_erf(float v) { return 0.5f * v * (1.f + erff(v * 0.7071067811865476f)); }
__global__ void __launch_bounds__(256) k_gather(float* __restrict__ H, const float* __restrict__ pnorm, const int* __restrict__ idx, const float* __restrict__ gw,
                                                 const float* __restrict__ Ein, const float* __restrict__ Eout, const float* __restrict__ plen, bf16* __restrict__ xn2) {
    const int lane = threadIdx.x & 63, tok = blockIdx.x * 4 + (threadIdx.x >> 6);
    float4* hr = (float4*)(H + (size_t)tok * DM) + lane; float4 hv[4], x[4], acc[4]; float ss = 0.f;
#pragma unroll
    for (int j = 0; j < 4; ++j) { hv[j] = hr[64 * j]; ss += hv[j].x * hv[j].x + hv[j].y * hv[j].y + hv[j].z * hv[j].z + hv[j].w * hv[j].w; acc[j] = make_float4(0.f, 0.f, 0.f, 0.f); }
    const float r = rsqrtf(wave_sum(ss) * (1.f / DM) + EPS);
#pragma unroll
    for (int j = 0; j < 4; ++j) { const float4 gg = ((const float4*)pnorm)[lane + 64 * j]; x[j] = make_float4(hv[j].x * r * gg.x, hv[j].y * r * gg.y, hv[j].z * r * gg.z, hv[j].w * r * gg.w); }
    for (int k = 0; k < 128; ++k) {
        const int e = idx[(size_t)tok * 128 + k]; const float g = gw[(size_t)tok * 128 + k];
        const float4* ur = (const float4*)(Ein + (size_t)e * DM) + lane; float d = 0.f;
#pragma unroll
        for (int j = 0; j < 4; ++j) { const float4 u = ur[64 * j]; d += x[j].x * u.x + x[j].y * u.y + x[j].z * u.z + x[j].w * u.w; }
        const float act = gelu_erf(wave_sum(d)) * g;
        const float4* er = (const float4*)(Eout + (size_t)e * DM) + lane;
#pragma unroll
        for (int j = 0; j < 4; ++j) { const float4 u = er[64 * j]; acc[j].x += act * u.x; acc[j].y += act * u.y; acc[j].z += act * u.z; acc[j].w += act * u.w; }
    }
    float s2 = 0.f;
#pragma unroll
    for (int j = 0; j < 4; ++j) { hv[j].x += acc[j].x; hv[j].y += acc[j].y; hv[j].z += acc[j].z; hv[j].w += acc[j].w; hr[64 * j] = hv[j]; s2 += hv[j].x * hv[j].x + hv[j].y * hv[j].y + hv[j].z * hv[j].z + hv[j].w * hv[j].w; }
    const float r2 = rsqrtf(wave_sum(s2) * (1.f / DM) + EPS);
#pragma unroll
    for (int j = 0; j < 4; ++j) { const float4 gg = ((const float4*)plen)[lane + 64 * j]; const size_t o = (size_t)tok * DM + 4 * (lane + 64 * j);
        xn2[o] = (bf16)f2bf(hv[j].x * r2 * gg.x); xn2[o + 1] = (bf16)f2bf(hv[j].y * r2 * gg.y); xn2[o + 2] = (bf16)f2bf(hv[j].z * r2 * gg.z); xn2[o + 3] = (bf16)f2bf(hv[j].w * r2 * gg.w); }
}
__global__ void k_final(float* __restrict__ H, const float* __restrict__ gate, const float* __restrict__ ple, size_t n) {
    for (size_t i = (size_t)blockIdx.x * blockDim.x + threadIdx.x; i < n; i += (size_t)gridDim.x * blockDim.x) H[i] = H[i] + ple[i] / (1.f + __expf(-gate[i]));
}

template <class Epi> static void launch_gemm(const bf16* A, const bf16* Bt, int M, int N, int K, Epi E, hipStream_t st) {
    static bool attr_set = false;
    if (!attr_set) { (void)hipFuncSetAttribute((const void*)k_gemm<Epi>, hipFuncAttributeMaxDynamicSharedMemorySize, 131072); attr_set = true; }
    pg8::Gemm g{A, Bt, M, N, K, 0};
    hipLaunchKernelGGL(k_gemm<Epi>, dim3(256), dim3(512), 131072, st, g, E);
}
extern "C" void kernel_launch(void* const* d_in, const int* in_sizes, int n_in, void* d_out, int out_size, void* d_ws, size_t ws_size, hipStream_t stream) {
    if (n_in != 24 || ws_size < WS_END) { fprintf(stderr, "kernel_launch: unexpected n_in %d / ws %zu\n", n_in, ws_size); return; }
    const float* x = (const float*)d_in[0]; const float* p = (const float*)d_in[1]; const float* mix_norm = (const float*)d_in[2]; const float* w_in = (const float*)d_in[3];
    const float* b_f = (const float*)d_in[4]; const float* gfq = (const float*)d_in[5]; const float* gfk = (const float*)d_in[6]; const float* gdq = (const float*)d_in[7]; const float* gdk = (const float*)d_in[8];
    const float* lq1 = (const float*)d_in[9]; const float* lk1 = (const float*)d_in[10]; const float* lq2 = (const float*)d_in[11]; const float* lk2 = (const float*)d_in[12];
    const float* gsub = (const float*)d_in[13]; const float* table = (const float*)d_in[14]; const float* w_out = (const float*)d_in[15]; const float* peer_norm = (const float*)d_in[16];
    const float* w_query = (const float*)d_in[17]; const float* sub_keys = (const float*)d_in[18]; const float* e_in = (const float*)d_in[19]; const float* e_out = (const float*)d_in[20];
    const float* ple_norm = (const float*)d_in[21]; const float* w_gate = (const float*)d_in[22]; const float* w_ple = (const float*)d_in[23];
    unsigned char* ws = (unsigned char*)d_ws; float* out = (float*)d_out;
    bf16* wt_in = (bf16*)(ws + WS_WT_IN); bf16* wt_out = (bf16*)(ws + WS_WT_OUT); bf16* wt_q = (bf16*)(ws + WS_WT_Q); bf16* wt_gate = (bf16*)(ws + WS_WT_GATE); bf16* wt_ple = (bf16*)(ws + WS_WT_PLE);
    bf16* xn = (bf16*)(ws + WS_XN); bf16* proj = (bf16*)(ws + WS_PROJ); bf16* O = (bf16*)(ws + WS_O); float* gate = (float*)(ws + WS_GATE); bf16* qkv = (bf16*)(ws + WS_QKV);
    bf16* qb = (bf16*)(ws + WS_Q); float* ple = (float*)(ws + WS_PLE); bf16* pbf = (bf16*)(ws + WS_PBF); int* idx = (int*)(ws + WS_IDX); float* gw = (float*)(ws + WS_G);
    float* logf = out;
    hipLaunchKernelGGL(k_transpose, dim3(NPROJ_PAD / 32, DM / 32), dim3(32, 8), 0, stream, w_in, DM, NPROJ, wt_in);
    hipLaunchKernelGGL(k_transpose, dim3(DM / 32, DM / 32), dim3(32, 8), 0, stream, w_out, DM, DM, wt_out);
    hipLaunchKernelGGL(k_transpose, dim3(2048 / 32, DM / 32), dim3(32, 8), 0, stream, w_query, DM, 2048, wt_q);
    hipLaunchKernelGGL(k_transpose, dim3(DM / 32, DM / 32), dim3(32, 8), 0, stream, w_gate, DM, DM, wt_gate);
    hipLaunchKernelGGL(k_transpose, dim3(DM / 32, 256 / 32), dim3(32, 8), 0, stream, w_ple, 256, DM, wt_ple);
    hipLaunchKernelGGL(k_rmsnorm, dim3(TOK / 4), dim3(256), 0, stream, x, mix_norm, xn, TOK);
    launch_gemm(xn, wt_in, TOK, NPROJ_PAD, DM, pg8::EpiBf16P{proj, NPROJ_PAD, 0}, stream);
    hipLaunchKernelGGL(k_qkvprep, dim3(TOK * 16 / 256), dim3(256), 0, stream, proj, qkv, logf, b_f, gfq, gfk, gdq, gdk);
    hipLaunchKernelGGL(k_cumsum, dim3(1), dim3(64), 0, stream, logf);
    hipLaunchKernelGGL(k_fox, dim3(SEQ / 256, 64), dim3(256), 0, stream, qkv, logf, O);
    hipLaunchKernelGGL(k_diff, dim3(SEQ / 256, 64), dim3(256), 0, stream, qkv, table, lq1, lk1, lq2, lk2, gsub, O);
    launch_gemm(O, wt_out, TOK, DM, DM, pg8::EpiF32{x, out, DM, 0}, stream);
    hipLaunchKernelGGL(k_rmsnorm, dim3(TOK / 4), dim3(256), 0, stream, out, peer_norm, xn, TOK);
    launch_gemm(xn, wt_q, TOK, 2048, DM, pg8::EpiBf16P{qb, 2048, 0}, stream);
    hipLaunchKernelGGL(k_topk, dim3(TOK * 8 / 4), dim3(256), 0, stream, qb, sub_keys, idx, gw);
    hipLaunchKernelGGL(k_gather, dim3(TOK / 4), dim3(256), 0, stream, out, peer_norm, idx, gw, e_in, e_out, ple_norm, xn);
    hipLaunchKernelGGL(k_cvt_bf16, dim3(2048), dim3(256), 0, stream, p, pbf, (size_t)TOK * 256);
    launch_gemm(xn, wt_gate, TOK, DM, DM, pg8::EpiF32{nullptr, gate, DM, 0}, stream);
    launch_gemm(pbf, wt_ple, TOK, DM, 256, pg8::EpiF32{nullptr, ple, DM, 0}, stream);
    hipLaunchKernelGGL(k_final, dim3(4096), dim3(256), 0, stream, out, gate, ple, (size_t)TOK * DM);
}
```

```cpp
#include <hip/hip_runtime.h>
#include <hip/hip_cooperative_groups.h>
#include <cstdio>
#include <cstdint>
#include <cmath>
namespace pg8 {
#define PG8_LAS __attribute__((address_space(3)))
typedef unsigned short bf16_t;
typedef short bf16x8 __attribute__((ext_vector_type(8)));
typedef float f32x4 __attribute__((ext_vector_type(4)));
typedef unsigned u32x4 __attribute__((ext_vector_type(4)));
constexpr int BM = 256, BK = 64, HALF = 128, HTB = HALF * BK * 2  , STAGE_BYTES = 8 * HTB, NXCD = 8, WGM = 8;

__host__ __device__ __forceinline__ int lds_byte(int r, int c) { const int st = (r >> 4) * 2 + (c >> 5), rr = r & 15, cc = c & 31, ob = rr * 64 + cc * 2; return st * 1024 + (ob ^ (((ob >> 9) & 1) << 5)); }
__host__ __device__ __forceinline__ void stage_rc(int b, int& R, int& C) { const int st = b / 1024, sb = b % 1024, swz = sb ^ (((sb >> 9) & 1) << 5); R = (st >> 1) * 16 + swz / 64; C = (st & 1) * 32 + (swz % 64) / 2; }
__host__ __device__ __forceinline__ int perm32(int rho) { const int n = rho >> 4, i = rho & 15; return 8 * (i >> 2) + 4 * n + (i & 3); }

struct Unit { int pm, pn; };
struct Gemm { const bf16_t* A; const bf16_t* Bt; int M, N, K, pad; };

struct StaticOrder {
    int nM, nN, nwg, G, c;
    __host__ __device__ void init(int M, int N, int G_, int c_) { nM = M / BM; nN = N / BM; nwg = nM * nN; G = G_; c = c_; }
    __host__ __device__ bool next(int i, Unit& u) const {
        const long L = (long)i * G + c; if (L >= nwg) return false;
        int wgid = (int)L; { const int q = nwg / NXCD, r = nwg % NXCD, xcd = wgid % NXCD, off = wgid / NXCD; wgid = (xcd < r ? xcd * (q + 1) : r * (q + 1) + (xcd - r) * q) + off; }
        const int nig = WGM * nN, gid = wgid / nig, fm = gid * WGM, gsz = (nM - fm) < WGM ? (nM - fm) : WGM;
        u.pm = fm + ((wgid % nig) % gsz); u.pn = (wgid % nig) / gsz; return true;
    }
    __device__ __forceinline__ void a_ready(const Unit&) const {}
    __device__ __forceinline__ void done(const Unit&) const {}
};

struct StaticOrderOne {
    StaticOrder base; int which;
    __host__ __device__ bool next(int i, Unit& u) const { return i == 0 ? base.next(which, u) : false; }
    __device__ __forceinline__ void a_ready(const Unit&) const {}
    __device__ __forceinline__ void done(const Unit&) const {}
};
__device__ __forceinline__ unsigned cvt_pk_bf16(float lo, float hi) { unsigned r; asm volatile("v_cvt_pk_bf16_f32 %0, %1, %2" : "=v"(r) : "v"(lo), "v"(hi)); return r; }
typedef float f32x2 __attribute__((ext_vector_type(2)));
struct EpiBf16P {
    static constexpr bool PERM = true, AFTER_DRAIN = false;
    bf16_t* O; int ldc, pad;
    __device__ __forceinline__ void operator()(const f32x4 (&acc)[2][2][4][2], const Unit& u, int wr, int wc, int fr, int fq) const {
        int t_o = threadIdx.x; asm volatile("" : "+v"(t_o)); const int fr_o = t_o & 15, fq_o = (t_o >> 4) & 3;
        const int row0 = u.pm * BM + wr * 64 + fr_o; const int col0 = u.pn * BM + wc * 32 + 8 * fq_o;
#pragma unroll
        for (int ai = 0; ai < 2; ++ai)
#pragma unroll
            for (int m = 0; m < 4; ++m) { bf16_t* rowp = O + (size_t)(row0 + ai * HALF + m * 16) * ldc + col0;
#pragma unroll
                for (int bj = 0; bj < 2; ++bj) { const f32x4 v0 = acc[ai][bj][m][0], v1 = acc[ai][bj][m][1];
                    u32x4 w; w.x = cvt_pk_bf16(v0[0], v0[1]); w.y = cvt_pk_bf16(v0[2], v0[3]); w.z = cvt_pk_bf16(v1[0], v1[1]); w.w = cvt_pk_bf16(v1[2], v1[3]);
                    *(u32x4*)(rowp + bj * HALF) = w; } }
    }
};
struct EpiQKV {
    static constexpr bool PERM = true, AFTER_DRAIN = false;
    bf16_t* qkv; const float* gains;
    static constexpr size_t SEC = (size_t)8 * 8 * 4096 * 64;
    __device__ __forceinline__ void operator()(const f32x4 (&acc)[2][2][4][2], const Unit& u, int wr, int wc, int fr_, int fq_) const {
        int t_o = threadIdx.x; asm volatile("" : "+v"(t_o)); const int fr = t_o & 15, fq = (t_o >> 4) & 3;
        const int sec = u.pn >> 1, head = 4 * (u.pn & 1) + wc;
        bf16_t* dst = qkv + (size_t)sec * SEC;
        const bool isq = (sec == 0 || sec == 3), isk = (sec == 1 || sec == 4), fox = sec < 3;
        f32x4 g[2][2];
        if (isq || isk) { const float* gp = gains + (sec == 0 ? 0 : sec == 1 ? 64 : sec == 3 ? 128 : 160);
#pragma unroll
            for (int bj = 0; bj < 2; ++bj)
#pragma unroll
                for (int n = 0; n < 2; ++n) g[bj][n] = *(const f32x4*)(gp + (fox ? 32 * bj : 0) + 8 * fq + 4 * n); }
        const float qs = isq ? (fox ? 0.125f * 1.4426950408889634f : 0.17677669529663687f * 1.4426950408889634f) : 1.f;
#pragma unroll
        for (int ai = 0; ai < 2; ++ai)
#pragma unroll
            for (int m = 0; m < 4; ++m) {
                const int r = u.pm * BM + ai * HALF + wr * 64 + m * 16 + fr, b = r >> 12, s = r & 4095, bh = b * 8 + head;
                f32x4 v[2][2];
#pragma unroll
                for (int bj = 0; bj < 2; ++bj)
#pragma unroll
                    for (int n = 0; n < 2; ++n) v[bj][n] = acc[ai][bj][m][n];
                if (isq || isk) {
                    float ss[2];
#pragma unroll
                    for (int bj = 0; bj < 2; ++bj) { const f32x4 a = v[bj][0], c = v[bj][1]; ss[bj] = (a[0] * a[0] + a[1] * a[1]) + (a[2] * a[2] + a[3] * a[3]) + (c[0] * c[0] + c[1] * c[1]) + (c[2] * c[2] + c[3] * c[3]); }
                    if (fox) { ss[0] += ss[1]; ss[1] = ss[0]; }
#pragma unroll
                    for (int bj = 0; bj < 2; ++bj) { ss[bj] += __shfl_xor(ss[bj], 16); ss[bj] += __shfl_xor(ss[bj], 32); }
#pragma unroll
                    for (int bj = 0; bj < 2; ++bj) { const float rr = __builtin_amdgcn_rsqf(ss[bj] * (fox ? 1.f / 64 : 1.f / 32) + 1e-6f) * qs;
#pragma unroll
                        for (int n = 0; n < 2; ++n) v[bj][n] = v[bj][n] * rr * g[bj][n]; }
                }
#pragma unroll
                for (int bj = 0; bj < 2; ++bj) {
                    u32x4 w; w.x = cvt_pk_bf16(v[bj][0][0], v[bj][0][1]); w.y = cvt_pk_bf16(v[bj][0][2], v[bj][0][3]); w.z = cvt_pk_bf16(v[bj][1][0], v[bj][1][1]); w.w = cvt_pk_bf16(v[bj][1][2], v[bj][1][3]);
                    size_t off;
                    if (isq) off = ((size_t)bh * 4096 + s) * 64 + 32 * bj + 8 * fq;
                    else if (isk) off = ((size_t)bh * 64 + (s >> 6)) * 4096 + (4 * bj + fq) * 512 + (s & 63) * 8;
                    else off = ((size_t)bh * 64 + (s >> 6)) * 4096 + bj * 2048 + (s & 63) * 32 + 8 * fq;
                    *(u32x4*)(dst + off) = w;
                }
            }
    }
};
struct EpiResNorm {
    static constexpr bool PERM = true, AFTER_DRAIN = false;
    const float* base; bf16_t* xb; float* rowpart;
    __device__ __forceinline__ void operator()(const f32x4 (&acc)[2][2][4][2], const Unit& u, int wr, int wc, int fr, int fq) const {
        int t_o = threadIdx.x; asm volatile("" : "+v"(t_o)); const int fr_o = t_o & 15, fq_o = (t_o >> 4) & 3;
        const int row0 = u.pm * BM + wr * 64 + fr_o; const int col0 = u.pn * BM + wc * 32 + 8 * fq_o;
#pragma unroll
        for (int ai = 0; ai < 2; ++ai)
#pragma unroll
            for (int m = 0; m < 4; ++m) { const int row = row0 + ai * HALF + m * 16; const size_t off = (size_t)row * 1024 + col0; float ss = 0.f;
#pragma unroll
                for (int bj = 0; bj < 2; ++bj) { const f32x4 o0 = acc[ai][bj][m][0] + *(const f32x4*)(base + off + bj * HALF), o1 = acc[ai][bj][m][1] + *(const f32x4*)(base + off + bj * HALF + 4);
                    ss += ((o0[0] * o0[0] + o0[1] * o0[1]) + (o0[2] * o0[2] + o0[3] * o0[3])) + ((o1[0] * o1[0] + o1[1] * o1[1]) + (o1[2] * o1[2] + o1[3] * o1[3]));
                    u32x4 w; w.x = cvt_pk_bf16(o0[0], o0[1]); w.y = cvt_pk_bf16(o0[2], o0[3]); w.z = cvt_pk_bf16(o1[0], o1[1]); w.w = cvt_pk_bf16(o1[2], o1[3]);
                    *(u32x4*)(xb + off + bj * HALF) = w; }
                ss += __shfl_xor(ss, 16); ss += __shfl_xor(ss, 32);
                if (fq_o == 0) rowpart[(size_t)row * 16 + u.pn * 4 + wc] = ss; }
    }
};
__device__ __forceinline__ float row_rstd(const float* rowpart, int row) {
    const f32x4* p = (const f32x4*)(rowpart + (size_t)row * 16); const f32x4 a = p[0], b = p[1], c = p[2], d = p[3];
    const float s = (((a[0] + a[1]) + (a[2] + a[3])) + ((b[0] + b[1]) + (b[2] + b[3]))) + (((c[0] + c[1]) + (c[2] + c[3])) + ((d[0] + d[1]) + (d[2] + d[3])));
    return __builtin_amdgcn_rsqf(s * (1.f / 1024) + 1e-6f);
}
struct EpiBf16Row {
    static constexpr bool PERM = true, AFTER_DRAIN = false;
    bf16_t* O; const float* rowpart; int ldc, pad;
    __device__ __forceinline__ void operator()(const f32x4 (&acc)[2][2][4][2], const Unit& u, int wr, int wc, int fr, int fq) const {
        int t_o = threadIdx.x; asm volatile("" : "+v"(t_o)); const int fr_o = t_o & 15, fq_o = (t_o >> 4) & 3;
        const int row0 = u.pm * BM + wr * 64 + fr_o; const int col0 = u.pn * BM + wc * 32 + 8 * fq_o;
#pragma unroll
        for (int ai = 0; ai < 2; ++ai)
#pragma unroll
            for (int m = 0; m < 4; ++m) { const int row = row0 + ai * HALF + m * 16; const float r = row_rstd(rowpart, row); bf16_t* rowp = O + (size_t)row * ldc + col0;
#pragma unroll
                for (int bj = 0; bj < 2; ++bj) { const f32x4 v0 = acc[ai][bj][m][0] * r, v1 = acc[ai][bj][m][1] * r;
                    u32x4 w; w.x = cvt_pk_bf16(v0[0], v0[1]); w.y = cvt_pk_bf16(v0[2], v0[3]); w.z = cvt_pk_bf16(v1[0], v1[1]); w.w = cvt_pk_bf16(v1[2], v1[3]);
                    *(u32x4*)(rowp + bj * HALF) = w; } }
    }
};
struct EpiGate {
    static constexpr bool PERM = true, AFTER_DRAIN = false;
    float* out; const bf16_t* hb; const bf16_t* ple; const float* r2part;
    __device__ __forceinline__ void operator()(const f32x4 (&acc)[2][2][4][2], const Unit& u, int wr, int wc, int fr, int fq) const {
        int t_o = threadIdx.x; asm volatile("" : "+v"(t_o)); const int fr_o = t_o & 15, fq_o = (t_o >> 4) & 3;
        const int row0 = u.pm * BM + wr * 64 + fr_o; const int col0 = u.pn * BM + wc * 32 + 8 * fq_o;
#pragma unroll
        for (int ai = 0; ai < 2; ++ai)
#pragma unroll
            for (int m = 0; m < 4; ++m) { const int row = row0 + ai * HALF + m * 16; const size_t off = (size_t)row * 1024 + col0;
                const f32x4 q0 = *(const f32x4*)(r2part + (size_t)row * 4);
                const float r2 = (-1.4426950408889634f / 32.f) * __builtin_amdgcn_rsqf(((q0[0] + q0[1]) + (q0[2] + q0[3])) * (1.f / 1024) + 1e-6f);
#pragma unroll
                for (int bj = 0; bj < 2; ++bj) { const size_t o2 = off + bj * HALF; const u32x4 hw = *(const u32x4*)(hb + o2), pw = *(const u32x4*)(ple + o2);
#pragma unroll
                    for (int n = 0; n < 2; ++n) { const f32x4 a = acc[ai][bj][m][n] * r2; const unsigned h01 = n ? hw.z : hw.x, h23 = n ? hw.w : hw.y, p01 = n ? pw.z : pw.x, p23 = n ? pw.w : pw.y; f32x4 o;
                        o[0] = __builtin_bit_cast(float, h01 << 16) + __builtin_bit_cast(float, p01 << 16) * __builtin_amdgcn_rcpf(1.f + __builtin_amdgcn_exp2f(a[0]));
                        o[1] = __builtin_bit_cast(float, h01 & 0xffff0000u) + __builtin_bit_cast(float, p01 & 0xffff0000u) * __builtin_amdgcn_rcpf(1.f + __builtin_amdgcn_exp2f(a[1]));
                        o[2] = __builtin_bit_cast(float, h23 << 16) + __builtin_bit_cast(float, p23 << 16) * __builtin_amdgcn_rcpf(1.f + __builtin_amdgcn_exp2f(a[2]));
                        o[3] = __builtin_bit_cast(float, h23 & 0xffff0000u) + __builtin_bit_cast(float, p23 & 0xffff0000u) * __builtin_amdgcn_rcpf(1.f + __builtin_amdgcn_exp2f(a[3]));
                        *(f32x4*)(out + o2 + 4 * n) = o; } } }
    }
};
template <class Epi, class Sched, bool ALIGN_EPI = false, bool SP2 = false, bool FP8 = false>
__device__ __forceinline__ void gemm_phase(PG8_LAS unsigned char* lds, const Gemm g, const Sched& S, const Epi& E) {
    int tid_o = threadIdx.x; asm volatile("" : "+v"(tid_o));
    const int tid = tid_o, wid = __builtin_amdgcn_readfirstlane(tid >> 6), lane = tid & 63, wr = wid >> 2, wc = wid & 3, fr = lane & 15, fq = lane >> 4;
    const int K = g.K, nt = K / BK;
    unsigned voffA[2], voffB[2];
#pragma unroll
    for (int i = 0; i < 2; ++i) { int R, C; stage_rc(tid * 16 + i * 8192, R, C); const int Rb = Epi::PERM ? ((R & ~31) + perm32(R & 31)) : R;
        voffA[i] = (unsigned)(R * K + C) * 2u; voffB[i] = (unsigned)(Rb * K + C) * 2u; }
    const size_t kstep = (size_t)(BK * 2);
    const size_t hstep = (size_t)HALF * K * 2;
    const size_t tstep = 2 * hstep;
    const unsigned ldsw = (unsigned)wid * 1024u;
    const int aoff = lds_byte(wr * 64 + fr, fq * 8), boff = lds_byte(wc * 32 + fr, fq * 8);
#define PG8_SA(b, h) (((b) * 2 + (h)) * HTB)
#define PG8_SB(b, h) ((4 + (b) * 2 + (h)) * HTB)
#define PG8_STAGE(bufoff, gbase, voff) do { _Pragma("unroll") for (int _i = 0; _i < 2; ++_i) \
        __builtin_amdgcn_global_load_lds((const unsigned*)((const char*)(gbase) + (voff)[_i]), (PG8_LAS unsigned*)(lds + (bufoff) + ldsw + _i * 8192), 16, 0, 0); } while (0)
    typedef int v4i_t __attribute__((ext_vector_type(4))); typedef int v8i_t __attribute__((ext_vector_type(8)));
#define PG8_LDA(dst, b, h) do { if constexpr (FP8) { _Pragma("unroll") for (int m = 0; m < 4; ++m) { const v4i_t lo_ = *(const PG8_LAS v4i_t*)(lds + PG8_SA(b, h) + aoff + m * 2048), hi_ = *(const PG8_LAS v4i_t*)(lds + PG8_SA(b, h) + aoff + m * 2048 + 1024); \
            dst##8[m] = __builtin_shufflevector(lo_, hi_, 0, 1, 2, 3, 4, 5, 6, 7); } } \
        else { _Pragma("unroll") for (int m = 0; m < 4; ++m) _Pragma("unroll") for (int k = 0; k < 2; ++k) dst[m][k] = *(const PG8_LAS bf16x8*)(lds + PG8_SA(b, h) + aoff + m * 2048 + k * 1024); } } while (0)
#define PG8_LDB(dst, b, h) do { if constexpr (FP8) { _Pragma("unroll") for (int n = 0; n < 2; ++n) { const v4i_t lo_ = *(const PG8_LAS v4i_t*)(lds + PG8_SB(b, h) + boff + n * 2048), hi_ = *(const PG8_LAS v4i_t*)(lds + PG8_SB(b, h) + boff + n * 2048 + 1024); \
            dst##8[n] = __builtin_shufflevector(lo_, hi_, 0, 1, 2, 3, 4, 5, 6, 7); } } \
        else { _Pragma("unroll") for (int n = 0; n < 2; ++n) _Pragma("unroll") for (int k = 0; k < 2; ++k) dst[n][k] = *(const PG8_LAS bf16x8*)(lds + PG8_SB(b, h) + boff + n * 2048 + k * 1024); } } while (0)
#define PG8_MMA(ai, bj, At, Bt) do { __builtin_amdgcn_s_setprio(1); if constexpr (FP8) { _Pragma("unroll") for (int m = 0; m < 4; ++m) _Pragma("unroll") for (int n = 0; n < 2; ++n) \
            asm volatile("v_mfma_f32_16x16x128_f8f6f4 %0, %1, %2, %0" : "+v"(acc[ai][bj][m][n]) : "v"(Bt##8[n]), "v"(At##8[m])); } \
        else { _Pragma("unroll") for (int m = 0; m < 4; ++m) _Pragma("unroll") for (int n = 0; n < 2; ++n) _Pragma("unroll") for (int k = 0; k < 2; ++k) \
            acc[ai][bj][m][n] = __builtin_amdgcn_mfma_f32_16x16x32_bf16(Bt[n][k], At[m][k], acc[ai][bj][m][n], 0, 0, 0); } __builtin_amdgcn_s_setprio(0); } while (0)
#define PG8_WAIT_V(n) asm volatile("s_waitcnt vmcnt(" #n ")" ::: "memory")
#define PG8_WAIT_L(n) asm volatile("s_waitcnt lgkmcnt(" #n ")" ::: "memory")
#define PG8_BAR __builtin_amdgcn_s_barrier()
#define PG8_SCHED __builtin_amdgcn_sched_barrier(0)
    Unit cur, nxt; int ui = 0;
    if (!S.next(0, cur)) return;
    f32x4 acc[2][2][4][2];
#pragma unroll
    for (int a = 0; a < 2; ++a)
#pragma unroll
        for (int b = 0; b < 2; ++b)
#pragma unroll
            for (int m = 0; m < 4; ++m)
#pragma unroll
                for (int n = 0; n < 2; ++n) acc[a][b][m][n] = (f32x4){0.f, 0.f, 0.f, 0.f};
    bf16x8 At[4][2], B0[2][2], B1[2][2]; v8i_t At8[4], B08[2], B18[2];
    const char* cA = (const char*)g.A + (size_t)cur.pm * tstep; const char* cB = (const char*)g.Bt + (size_t)cur.pn * tstep;
    S.a_ready(cur);
    if constexpr (SP2) {
        PG8_STAGE(PG8_SB(0, 0), cB, voffB); PG8_STAGE(PG8_SB(0, 1), cB + hstep, voffB); PG8_STAGE(PG8_SA(0, 0), cA, voffA); PG8_STAGE(PG8_SA(0, 1), cA + hstep, voffA);
        if (wr == 1) PG8_BAR;
        PG8_WAIT_V(2); PG8_BAR;
        PG8_STAGE(PG8_SB(1, 0), cB + kstep, voffB); PG8_STAGE(PG8_SA(1, 0), cA + kstep, voffA); PG8_STAGE(PG8_SB(1, 1), cB + hstep + kstep, voffB);
        PG8_WAIT_V(6); PG8_BAR;
    } else {
        PG8_STAGE(PG8_SB(0, 0), cB, voffB); PG8_STAGE(PG8_SA(0, 0), cA, voffA); PG8_STAGE(PG8_SB(0, 1), cB + hstep, voffB); PG8_STAGE(PG8_SA(0, 1), cA + hstep, voffA);
        if (wr == 1) PG8_BAR;
        PG8_WAIT_V(4); PG8_BAR;
        PG8_STAGE(PG8_SB(1, 0), cB + kstep, voffB); PG8_STAGE(PG8_SA(1, 0), cA + kstep, voffA); PG8_STAGE(PG8_SB(1, 1), cB + hstep + kstep, voffB);
        PG8_WAIT_V(6); PG8_BAR;
    }
    for (;;) {
        const bool has_next = S.next(ui + 1, nxt);
        const char* nA = has_next ? (const char*)g.A + (size_t)nxt.pm * tstep : cA; const char* nB = has_next ? (const char*)g.Bt + (size_t)nxt.pn * tstep : cB;
        for (int t = 0; t < nt; t += 2) {
            const bool last = (t == nt - 2);
            const char* a1 = cA + (size_t)(t + 1) * kstep;
            const char* a2 = last ? nA : cA + (size_t)(t + 2) * kstep; const char* b2 = last ? nB : cB + (size_t)(t + 2) * kstep;
            const char* a3 = a2 + kstep; const char* b3 = b2 + kstep;
            if (last && has_next) S.a_ready(nxt);
            if constexpr (SP2) {
            PG8_LDB(B0, 0, 0); PG8_LDB(B1, 0, 1); PG8_SCHED; PG8_LDA(At, 0, 0); PG8_STAGE(PG8_SA(1, 1), a1 + hstep, voffA);
            PG8_WAIT_V(8); PG8_WAIT_L(0); PG8_BAR; PG8_MMA(0, 0, At, B0); PG8_MMA(0, 1, At, B1); PG8_BAR; PG8_SCHED;
            PG8_LDA(At, 0, 1); PG8_STAGE(PG8_SB(0, 0), b2, voffB); PG8_STAGE(PG8_SB(0, 1), b2 + hstep, voffB); PG8_STAGE(PG8_SA(0, 0), a2, voffA);
            PG8_WAIT_V(8); PG8_WAIT_L(0); PG8_BAR; PG8_MMA(1, 0, At, B0); PG8_MMA(1, 1, At, B1); PG8_BAR; PG8_SCHED;
            PG8_LDB(B0, 1, 0); PG8_LDB(B1, 1, 1); PG8_SCHED; PG8_LDA(At, 1, 0); PG8_STAGE(PG8_SA(0, 1), a2 + hstep, voffA);
            PG8_WAIT_V(8); PG8_WAIT_L(0); PG8_BAR; PG8_MMA(0, 0, At, B0); PG8_MMA(0, 1, At, B1); PG8_BAR; PG8_SCHED;
            PG8_LDA(At, 1, 1); PG8_STAGE(PG8_SB(1, 0), b3, voffB); PG8_STAGE(PG8_SB(1, 1), b3 + hstep, voffB); PG8_STAGE(PG8_SA(1, 0), a3, voffA);
            PG8_WAIT_V(8); PG8_WAIT_L(0); PG8_BAR; PG8_MMA(1, 0, At, B0); PG8_MMA(1, 1, At, B1); PG8_BAR; PG8_SCHED;
            } else {
            PG8_LDB(B0, 0, 0); PG8_SCHED; PG8_LDA(At, 0, 0); PG8_STAGE(PG8_SA(1, 1), a1 + hstep, voffA);
            PG8_WAIT_L(8); PG8_BAR; PG8_WAIT_L(0); PG8_MMA(0, 0, At, B0); PG8_BAR; PG8_SCHED;
            PG8_LDB(B1, 0, 1); PG8_STAGE(PG8_SB(0, 0), b2, voffB);
            PG8_BAR; PG8_WAIT_L(0); PG8_MMA(0, 1, At, B1); PG8_BAR;
            PG8_LDA(At, 0, 1); PG8_STAGE(PG8_SA(0, 0), a2, voffA);
            PG8_BAR; PG8_WAIT_L(0); PG8_MMA(1, 0, At, B0); PG8_BAR; PG8_SCHED;
            PG8_STAGE(PG8_SB(0, 1), b2 + hstep, voffB);
            PG8_WAIT_V(6); PG8_BAR; PG8_MMA(1, 1, At, B1); PG8_BAR;
            PG8_LDB(B0, 1, 0); PG8_SCHED; PG8_LDA(At, 1, 0); PG8_STAGE(PG8_SA(0, 1), a2 + hstep, voffA);
            PG8_WAIT_L(8); PG8_BAR; PG8_WAIT_L(0); PG8_MMA(0, 0, At, B0); PG8_BAR; PG8_SCHED;
            PG8_LDB(B1, 1, 1); PG8_STAGE(PG8_SB(1, 0), b3, voffB);
            PG8_BAR; PG8_WAIT_L(0); PG8_MMA(0, 1, At, B1); PG8_BAR;
            PG8_LDA(At, 1, 1); PG8_STAGE(PG8_SA(1, 0), a3, voffA);
            PG8_BAR; PG8_WAIT_L(0); PG8_MMA(1, 0, At, B0); PG8_BAR; PG8_SCHED;
            PG8_STAGE(PG8_SB(1, 1), b3 + hstep, voffB);
            PG8_WAIT_V(6); PG8_BAR; PG8_MMA(1, 1, At, B1); PG8_BAR;
            }
        }
        if constexpr (ALIGN_EPI) { if (wr == 0) PG8_BAR; }
        if constexpr (FP8) asm volatile("s_nop 15\n\ts_nop 15" ::: "memory");
        if constexpr (!Epi::AFTER_DRAIN) { E(acc, cur, wr, wc, fr, fq); S.done(cur); }
        if (!has_next) break;
#pragma unroll
        for (int a = 0; a < 2; ++a)
#pragma unroll
            for (int b = 0; b < 2; ++b)
#pragma unroll
                for (int m = 0; m < 4; ++m)
#pragma unroll
                    for (int n = 0; n < 2; ++n) acc[a][b][m][n] = (f32x4){0.f, 0.f, 0.f, 0.f};
        cur = nxt; cA = nA; cB = nB; ++ui;
        if constexpr (ALIGN_EPI) { if (wr == 1) PG8_BAR; }
    }
    PG8_WAIT_V(0);
    if constexpr (!ALIGN_EPI) { if (wr == 0) PG8_BAR; }
    PG8_BAR;
    if constexpr (Epi::AFTER_DRAIN) { E.fused(acc, cur, wr, wc, fr, fq, lds, wid, lane); S.done(cur); }
#undef PG8_SA
#undef PG8_SB
#undef PG8_STAGE
#undef PG8_LDA
#undef PG8_LDB
#undef PG8_MMA
#undef PG8_WAIT_V
#undef PG8_WAIT_L
#undef PG8_BAR
#undef PG8_SCHED
}
}

constexpr int NB = 8, SEQ = 4096, DM = 1024, TOK = NB * SEQ, NPROJ = 3080, NPROJ_PAD = 3328;
constexpr int OFF_QF = 0, OFF_KF = 512, OFF_VF = 1024, OFF_FL = 1536, OFF_QD = 1544, OFF_KD = 2056, OFF_VD = 2568;
constexpr float EPS = 1e-6f;
constexpr size_t MiB = 1u << 20;
constexpr size_t WS_WT_IN = 0, WS_WT_OUT = 7 * MiB, WS_WT_Q = 9 * MiB, WS_WT_GATE = 13 * MiB, WS_WT_PLE = 15 * MiB, WS_XN = 16 * MiB,
                 WS_PROJ = 80 * MiB, WS_O = 80 * MiB, WS_GATE = 80 * MiB, WS_QKV = 288 * MiB, WS_Q = 288 * MiB, WS_PLE = 288 * MiB, WS_PBF = 416 * MiB,
                 WS_IDX = 480 * MiB, WS_G = 496 * MiB, WS_END = 512 * MiB;
constexpr size_t QKV_SEC = (size_t)NB * 8 * SEQ * 64;

typedef unsigned short bf16;
#define LAS __attribute__((address_space(3)))
__device__ __forceinline__ unsigned f2bf(float f) { unsigned u = __builtin_bit_cast(unsigned, f); return (u + 0x7fffu + ((u >> 16) & 1u)) >> 16; }
__device__ __forceinline__ float bf2f(unsigned short u) { return __builtin_bit_cast(float, (unsigned)u << 16); }
__device__ __forceinline__ float wave_sum(float v) {
    v += __builtin_bit_cast(float, __builtin_amdgcn_mov_dpp(__builtin_bit_cast(int, v), 0xB1, 0xf, 0xf, true));
    v += __builtin_bit_cast(float, __builtin_amdgcn_mov_dpp(__builtin_bit_cast(int, v), 0x4E, 0xf, 0xf, true));
    v += __builtin_bit_cast(float, __builtin_amdgcn_mov_dpp(__builtin_bit_cast(int, v), 0x141, 0xf, 0xf, true));
    v += __builtin_bit_cast(float, __builtin_amdgcn_mov_dpp(__builtin_bit_cast(int, v), 0x140, 0xf, 0xf, true));
    { auto r = __builtin_amdgcn_permlane16_swap(__float_as_uint(v), __float_as_uint(v), false, false); v = __uint_as_float(r[0]) + __uint_as_float(r[1]); }
    { auto r = __builtin_amdgcn_permlane32_swap(__float_as_uint(v), __float_as_uint(v), false, false); v = __uint_as_float(r[0]) + __uint_as_float(r[1]); }
    return v;
}
__device__ __forceinline__ float wave_max(float v) {
    v = fmaxf(v, __builtin_bit_cast(float, __builtin_amdgcn_mov_dpp(__builtin_bit_cast(int, v), 0xB1, 0xf, 0xf, true)));
    v = fmaxf(v, __builtin_bit_cast(float, __builtin_amdgcn_mov_dpp(__builtin_bit_cast(int, v), 0x4E, 0xf, 0xf, true)));
    v = fmaxf(v, __builtin_bit_cast(float, __builtin_amdgcn_mov_dpp(__builtin_bit_cast(int, v), 0x141, 0xf, 0xf, true)));
    v = fmaxf(v, __builtin_bit_cast(float, __builtin_amdgcn_mov_dpp(__builtin_bit_cast(int, v), 0x140, 0xf, 0xf, true)));
    { auto r = __builtin_amdgcn_permlane16_swap(__float_as_uint(v), __float_as_uint(v), false, false); v = fmaxf(__uint_as_float(r[0]), __uint_as_float(r[1])); }
    { auto r = __builtin_amdgcn_permlane32_swap(__float_as_uint(v), __float_as_uint(v), false, false); v = fmaxf(__uint_as_float(r[0]), __uint_as_float(r[1])); }
    return v;
}
__device__ __forceinline__ int tid_opaque() { int t = threadIdx.x; asm volatile("" : "+v"(t)); return t; }
__device__ __forceinline__ float log_sigmoid(float z) { return fminf(z, 0.f) - log1pf(expf(-fabsf(z))); }

typedef unsigned v4u __attribute__((ext_vector_type(4)));
typedef float f32x4 __attribute__((ext_vector_type(4)));
#define LDS_WAIT() asm volatile("s_waitcnt lgkmcnt(0)" ::: "memory")
__device__ __forceinline__ unsigned pk2(float lo, float hi) { return f2bf(lo) | (f2bf(hi) << 16); }
__device__ __forceinline__ void tr_item(const float* W, int ldw, int K, int src_col0, bf16* WT, int dst_row0, int kb, LAS float* scr, int lane, const float* gk = nullptr) {
    const int k0 = 64 * kb;
#pragma unroll 8
    for (int i = 0; i < 32; ++i) { const int kk = 2 * i + (lane >> 5); float w = W[(size_t)(k0 + kk) * ldw + src_col0 + (lane & 31)]; if (gk) w *= gk[k0 + kk]; scr[kk * 33 + (lane & 31)] = w; }
    LDS_WAIT(); asm volatile("" ::: "memory");
    const int c = lane & 7;
#pragma unroll
    for (int j = 0; j < 4; ++j) { const int n = (lane >> 3) + 8 * j; const LAS float* s = scr + (8 * c) * 33 + n;
        v4u o; o.x = pk2(s[0 * 33], s[1 * 33]); o.y = pk2(s[2 * 33], s[3 * 33]); o.z = pk2(s[4 * 33], s[5 * 33]); o.w = pk2(s[6 * 33], s[7 * 33]);
        *(v4u*)(WT + (size_t)(dst_row0 + n) * K + k0 + 8 * c) = o; }
    LDS_WAIT(); asm volatile("" ::: "memory");
}
__device__ __forceinline__ void tr_item8(const float* W, int ldw, int K, int src_col0, unsigned char* WT8, int dst_row0, int kb, LAS float* scr, int lane, float scale, const float* gk) {
    const int k0 = 64 * kb;
    { float wv[32];
#pragma unroll
      for (int i = 0; i < 32; ++i) { const int kk = 2 * i + (lane >> 5); wv[i] = W[(size_t)(k0 + kk) * ldw + src_col0 + (lane & 31)]; }
#pragma unroll
      for (int i = 0; i < 32; ++i) scr[(2 * i + (lane >> 5)) * 33 + (lane & 31)] = wv[i] * (scale * gk[k0 + 2 * i + (lane >> 5)]); }
    LDS_WAIT(); asm volatile("" ::: "memory");
    const int c = lane & 7;
#pragma unroll
    for (int j = 0; j < 4; ++j) { const int n = (lane >> 3) + 8 * j; const LAS float* s = scr + (8 * c) * 33 + n;
        int lo = 0, hi = 0; lo = __builtin_amdgcn_cvt_pk_fp8_f32(s[0 * 33], s[1 * 33], lo, false); lo = __builtin_amdgcn_cvt_pk_fp8_f32(s[2 * 33], s[3 * 33], lo, true);
        hi = __builtin_amdgcn_cvt_pk_fp8_f32(s[4 * 33], s[5 * 33], hi, false); hi = __builtin_amdgcn_cvt_pk_fp8_f32(s[6 * 33], s[7 * 33], hi, true);
        typedef unsigned u32x2_t __attribute__((ext_vector_type(2))); u32x2_t o; o.x = (unsigned)lo; o.y = (unsigned)hi;
        *(u32x2_t*)(WT8 + (size_t)(dst_row0 + n) * K + k0 + 8 * c) = o; }
    LDS_WAIT(); asm volatile("" ::: "memory");
}
__device__ __forceinline__ int win_src_col(int g) {
    const int tile = g >> 3, bj = (g >> 2) & 1, wc = g & 3, sec = tile >> 1, head = 4 * (tile & 1) + wc;
    const int base = sec == 0 ? OFF_QF : sec == 1 ? OFF_KF : sec == 2 ? OFF_VF : sec == 3 ? OFF_QD : sec == 4 ? OFF_KD : OFF_VD;
    return base + head * 64 + 32 * bj;
}
__device__ __forceinline__ void cvt8(const float* __restrict__ in, bf16* __restrict__ out, size_t n8, size_t gt, size_t ngt) {
    for (size_t i = gt; i < n8; i += ngt) { const f32x4 a = ((const f32x4*)in)[2 * i], b = ((const f32x4*)in)[2 * i + 1];
        v4u o; o.x = pk2(a[0], a[1]); o.y = pk2(a[2], a[3]); o.z = pk2(b[0], b[1]); o.w = pk2(b[2], b[3]); ((v4u*)out)[i] = o; }
}
__device__ __forceinline__ float reduce8(const float (&a8)[8], int lane) {
    const bool b0 = lane & 1, b1 = lane & 2, b2 = lane & 4; float c4[4], c2[2];
#pragma unroll
    for (int i = 0; i < 4; ++i) { const float keep = b0 ? a8[4 + i] : a8[i], send = b0 ? a8[i] : a8[4 + i]; c4[i] = keep + __builtin_bit_cast(float, __builtin_amdgcn_mov_dpp(__builtin_bit_cast(int, send), 0xB1, 0xf, 0xf, true)); }
#pragma unroll
    for (int i = 0; i < 2; ++i) { const float keep = b1 ? c4[2 + i] : c4[i], send = b1 ? c4[i] : c4[2 + i]; c2[i] = keep + __builtin_bit_cast(float, __builtin_amdgcn_mov_dpp(__builtin_bit_cast(int, send), 0x4E, 0xf, 0xf, true)); }
    float fl; { const float keep = b2 ? c2[1] : c2[0], send = b2 ? c2[0] : c2[1];
        const float up = __builtin_bit_cast(float, __builtin_amdgcn_mov_dpp(__builtin_bit_cast(int, send), 0x104, 0xf, 0xf, true)), dn = __builtin_bit_cast(float, __builtin_amdgcn_mov_dpp(__builtin_bit_cast(int, send), 0x114, 0xf, 0xf, true));
        fl = keep + (b2 ? dn : up); }
    fl += __builtin_bit_cast(float, __builtin_amdgcn_mov_dpp(__builtin_bit_cast(int, fl), 0x128, 0xf, 0xf, true));
    { auto r_ = __builtin_amdgcn_permlane16_swap(__float_as_uint(fl), __float_as_uint(fl), false, false); fl = __uint_as_float(r_[0]) + __uint_as_float(r_[1]); }
    { auto r_ = __builtin_amdgcn_permlane32_swap(__float_as_uint(fl), __float_as_uint(fl), false, false); fl = __uint_as_float(r_[0]) + __uint_as_float(r_[1]); }
    return fl;
}
struct P0Args { const float *x, *p, *mix_norm, *w_in, *b_f, *w_out, *w_query, *sub_keys, *e_in, *e_out, *w_gate, *w_ple;
                bf16 *wt_in, *wt_out, *wt_q, *wt_gate, *wt_ple, *skb; unsigned char *ein8, *eout8; float *sin, *sout; bf16 *pbf, *xn; float *cloc, *ttot; const float *gfq, *gfk, *gdq, *gdk; float* gains; const float *lq1, *lk1, *lq2, *lk2, *table; float* consts; const float *peer_norm, *ple_norm; };
__device__ __forceinline__ void ph_p0(const P0Args& A, unsigned char* lds, const int sect, const int part = -1) {
    const int tid = tid_opaque(), lane = tid & 63, wave = tid >> 6;
    const int gw = blockIdx.x * 8 + wave, ngw = gridDim.x * 8;
    if ((sect & 8) && blockIdx.x == 0 && tid < 192) A.gains[tid] = tid < 64 ? A.gfq[tid] : tid < 128 ? A.gfk[tid - 64] : tid < 160 ? A.gdq[tid - 128] : A.gdk[tid - 160];
    if ((sect & 8) && blockIdx.x == 0 && wave == 0) {
        const float mqf = wave_max(fabsf(A.gfq[lane])), mkf = wave_max(fabsf(A.gfk[lane]));
        const int l32 = lane & 31; const bool lo = lane < 32;
        const float mqd = wave_max(fabsf(A.gdq[l32])), mkd = wave_max(fabsf(A.gdk[l32]));
        float mb[8];
#pragma unroll
        for (int h = 0; h < 8; ++h) mb[h] = wave_max(A.table[l32 * 8 + h]);
        const float s1 = wave_sum(lo ? A.lq1[l32] * A.lk1[l32] : 0.f), s2 = wave_sum(lo ? A.lq2[l32] * A.lk2[l32] : 0.f);
        if (lane == 0) { A.consts[0] = 8.f * mqf * mkf * 1.4426950408889634f;
#pragma unroll
            for (int h = 0; h < 8; ++h) A.consts[1 + h] = (5.656854249492381f * mqd * mkd + mb[h]) * 1.4426950408889634f;
            A.consts[9] = expf(s1) - expf(s2) + 0.2f; } }
    if (sect & 1) { LAS float* scr = (LAS float*)(lds) + wave * (64 * 33);
      for (int it = gw; it < 96 * 16; it += ngw) { const int g = it % 96, kb = it / 96; tr_item(A.w_in, NPROJ, DM, win_src_col(g), A.wt_in, 32 * g, kb, scr, lane); } }
    if (sect & 16) { LAS float* scr = (LAS float*)(lds) + wave * (64 * 33);
      constexpr int I_OUT = 32 * 16, I_Q = 64 * 16, I_G = 32 * 16, I_P = 32 * 4, NIT = I_OUT + I_Q + I_G + I_P;
      for (int it = gw; it < NIT; it += ngw) { int r = it;
          if (r < I_OUT) { const int g = r % 32, kb = r / 32; tr_item(A.w_out, DM, DM, 32 * g, A.wt_out, 32 * g, kb, scr, lane); continue; }
          r -= I_OUT;
          if (r < I_Q) { const int g = r % 64, kb = r / 64; tr_item(A.w_query, 2048, DM, 32 * g, A.wt_q, 32 * g, kb, scr, lane, A.peer_norm); continue; }
          r -= I_Q;
          if (r < I_G) { const int g = r % 32, kb = r / 32; tr_item8(A.w_gate, DM, DM, 32 * g, (unsigned char*)A.wt_gate, 32 * g, kb, scr, lane, 32.f, A.ple_norm); continue; }
          r -= I_G;
          { const int g = r % 32, kb = r / 32; tr_item(A.w_ple, DM, 256, 32 * g, A.wt_ple, 32 * g, kb, scr, lane); } } }
    { const size_t gt = (size_t)blockIdx.x * 512 + tid, ngt = (size_t)gridDim.x * 512;
      if (sect & 2) cvt8(A.sub_keys, A.skb, (size_t)8 * 2 * 128 * 128 / 8, gt, ngt);
      if (sect & 64) cvt8(A.p, A.pbf, (size_t)TOK * 256 / 8, gt, ngt);
    }
#pragma unroll 1
    for (int tb = (sect & 4) ? 0 : 1; tb < ((sect & 32) ? 2 : 1); ++tb) { const bool second = tb == 1; const float* tsrc = second ? A.e_out : A.e_in; unsigned char* tdst = second ? A.eout8 : A.ein8; float* sdst = second ? A.sout : A.sin;
        f32x4 pn[4];
#pragma unroll
        for (int j = 0; j < 4; ++j) { pn[j] = ((const f32x4*)A.peer_norm)[lane * 4 + j]; if (second) pn[j] = (f32x4){1.f, 1.f, 1.f, 1.f}; }
        const int elo = part < 0 ? 0 : 8192 * part, ehi = part < 0 ? 16384 : 8192 * (part + 1);
#pragma unroll 1
        for (int e0 = elo + gw; e0 < ehi; e0 += 4 * ngw) { f32x4 v[4][4];
#pragma unroll
            for (int q = 0; q < 4; ++q) { const int e = e0 + q * ngw; if (e < ehi) { const f32x4* src = (const f32x4*)(tsrc + (size_t)e * DM) + lane * 4;
#pragma unroll
                for (int j = 0; j < 4; ++j) v[q][j] = src[j]; } }
#pragma unroll
            for (int q = 0; q < 4; ++q) { const int e = e0 + q * ngw; if (e < ehi) { float mx = 0.f;
#pragma unroll
                for (int j = 0; j < 4; ++j) { v[q][j] = v[q][j] * pn[j]; mx = fmaxf(fmaxf(mx, fmaxf(fabsf(v[q][j][0]), fabsf(v[q][j][1]))), fmaxf(fabsf(v[q][j][2]), fabsf(v[q][j][3]))); }
                mx = wave_max(mx);
                {
                    float ssq = 0.f;
#pragma unroll
                    for (int j = 0; j < 4; ++j) ssq += (v[q][j][0] * v[q][j][0] + v[q][j][1] * v[q][j][1]) + (v[q][j][2] * v[q][j][2] + v[q][j][3] * v[q][j][3]);
                    ssq = wave_sum(ssq);
                    const float s1 = mx > 0.f ? 0.35f * sqrtf(ssq * (1.f / 1024.f)) : 1.f, s2 = mx > 0.f ? mx * (1.f / 7.f) : 1.f;
                    float clip = 0.f; const float lim = 7.f * s1;
#pragma unroll
                    for (int j = 0; j < 4; ++j)
#pragma unroll
                        for (int c = 0; c < 4; ++c) { const float ex = fmaxf(fabsf(v[q][j][c]) - lim, 0.f); clip = __builtin_fmaf(ex, ex, clip); }
                    clip = wave_sum(clip);
                    const float e1 = (1024.f / 12.f) * s1 * s1 + clip, e2 = (1024.f / 12.f) * s2 * s2;
                    const float sc = e1 <= e2 ? s1 : s2, inv = 1.f / sc; unsigned dw[2] = {0u, 0u};
#pragma unroll
                    for (int j = 0; j < 4; ++j)
#pragma unroll
                        for (int c = 0; c < 4; ++c) { int qi = (int)fminf(fmaxf(rintf(v[q][j][c] * inv), -7.f), 7.f); if (second && !(c & 1)) qi += 8;
                            dw[j >> 1] |= (unsigned)(qi & 15) << (4 * (4 * (j & 1) + c)); }
                    typedef unsigned u32x2_t __attribute__((ext_vector_type(2))); u32x2_t o; o.x = dw[0]; o.y = dw[1];
                    *(u32x2_t*)(tdst + (((size_t)(lane >> 4) * 16384 + e) << 7) + (lane & 15) * 8) = o;
                    if (lane == 0) sdst[e] = sc;
                } } } } }
    __syncthreads();
    if (!(sect & 8)) return;
    { float* wf = (float*)lds;
      float* lf = (float*)(lds + 32768);
      for (int i = tid; i < 8 * DM; i += 512) { const int h = i >> 10, k = i & 1023; wf[i] = A.w_in[(size_t)k * NPROJ + OFF_FL + h]; }
      __syncthreads();
      f32x4 gg[4];
#pragma unroll
      for (int j = 0; j < 4; ++j) gg[j] = ((const f32x4*)A.mix_norm)[lane + 64 * j];
      for (int chunk = blockIdx.x; chunk < TOK / 128; chunk += gridDim.x) {
          f32x4 vb[2][2][4];
#define P0_LOADPAIR(buf, pp_) do { _Pragma("unroll") for (int u_ = 0; u_ < 2; ++u_) { const f32x4* xr_ = (const f32x4*)(A.x + ((size_t)chunk * 128 + wave * 16 + 2 * (pp_) + u_) * DM) + lane; \
              _Pragma("unroll") for (int j = 0; j < 4; ++j) vb[buf][u_][j] = xr_[64 * j]; } } while (0)
          P0_LOADPAIR(0, 0);
#pragma unroll 1
          for (int pg = 0; pg < 4; ++pg) {
#pragma unroll
            for (int q = 0; q < 2; ++q) { const int pp = 2 * pg + q; const int rl0 = wave * 16 + 2 * pp; const size_t row0 = (size_t)chunk * 128 + rl0;
              if (pp + 1 < 8) P0_LOADPAIR(q ^ 1, pp + 1);
              f32x4 v[2][4]; float ss[2] = {0.f, 0.f}, r[2];
#pragma unroll
              for (int u = 0; u < 2; ++u)
#pragma unroll
                  for (int j = 0; j < 4; ++j) { v[u][j] = vb[q][u][j];
#pragma unroll
                      for (int e = 0; e < 4; ++e) ss[u] = __builtin_fmaf(v[u][j][e], v[u][j][e], ss[u]); }
              ss[0] = wave_sum(ss[0]); ss[1] = wave_sum(ss[1]);
#pragma unroll
              for (int u = 0; u < 2; ++u) r[u] = rsqrtf(ss[u] * (1.f / DM) + EPS);
#pragma unroll
              for (int u = 0; u < 2; ++u)
#pragma unroll
                  for (int j = 0; j < 4; ++j) { v[u][j] = v[u][j] * r[u] * gg[j]; const unsigned long long o = (unsigned long long)pg8::cvt_pk_bf16(v[u][j][0], v[u][j][1]) | ((unsigned long long)pg8::cvt_pk_bf16(v[u][j][2], v[u][j][3]) << 32);
                      ((unsigned long long*)(A.xn + (row0 + u) * DM))[lane + 64 * j] = o; }
              float a8[2][8];
#pragma unroll
              for (int h = 0; h < 8; ++h) { float a0 = 0.f, a1 = 0.f;
#pragma unroll
                  for (int j = 0; j < 4; ++j) { const f32x4 w = ((const f32x4*)(wf + h * DM))[lane + 64 * j];
#pragma unroll
                      for (int e = 0; e < 4; ++e) { a0 = __builtin_fmaf(v[0][j][e], w[e], a0); a1 = __builtin_fmaf(v[1][j][e], w[e], a1); } }
                  a8[0][h] = a0; a8[1][h] = a1; }
              const float fl0 = reduce8(a8[0], lane), fl1 = reduce8(a8[1], lane);
              const int hsel = 4 * (lane & 1) + (lane & 2) + ((lane >> 2) & 1);
              if (lane < 8) { const float bf = A.b_f[hsel]; lf[rl0 * 8 + hsel] = fl0 + bf; lf[(rl0 + 1) * 8 + hsel] = fl1 + bf; }
            } }
#undef P0_LOADPAIR
          __syncthreads();
          { const int h = wave; const float v0 = log_sigmoid(lf[(2 * lane) * 8 + h]), v1 = log_sigmoid(lf[(2 * lane + 1) * 8 + h]); float incl = v0 + v1;
#pragma unroll
            for (int d = 1; d < 64; d <<= 1) { const float t = __shfl_up(incl, d); if (lane >= d) incl += t; }
            A.cloc[((size_t)chunk * 128 + 2 * lane) * 8 + h] = incl - v1; A.cloc[((size_t)chunk * 128 + 2 * lane + 1) * 8 + h] = incl;
            if (lane == 63) A.ttot[chunk * 8 + h] = incl; }
          __syncthreads();
      } }
}

namespace att {
typedef short bf16x8 __attribute__((ext_vector_type(8)));
typedef short s16x4 __attribute__((ext_vector_type(4)));
typedef short v4i16_t __attribute__((ext_vector_type(4)));
typedef float f32x16 __attribute__((ext_vector_type(16)));
typedef float f32x4 __attribute__((ext_vector_type(4)));
typedef unsigned u32x4 __attribute__((ext_vector_type(4)));
typedef unsigned u32x2 __attribute__((ext_vector_type(2)));
typedef LAS const char* lptr;
constexpr int SLOTB = 16384, NSLOT = 3, L_CS = NSLOT * SLOTB, L_LUT = L_CS + 16384, L_SB = L_LUT + 1024, L_OST = L_SB + 256, OST_ROW = 144, L_END = L_OST + 8 * 32 * OST_ROW;
constexpr float LOG2E = 1.4426950408889634f;
__device__ __forceinline__ void glds16(const void* gsrc, unsigned lds_dst) { unsigned keep;
    asm volatile("s_mov_b32 %0, m0\n\ts_mov_b32 m0, %2\n\ts_nop 0\n\tglobal_load_lds_dwordx4 %1, off\n\ts_mov_b32 m0, %0" : "=&s"(keep) : "v"(gsrc), "s"(lds_dst) : "memory"); }
__device__ __forceinline__ s16x4 vtr(lptr p) { return __builtin_bit_cast(s16x4, __builtin_amdgcn_ds_read_tr16_b64_v4i16((LAS v4i16_t*)p)); }
__device__ __forceinline__ unsigned cvtpk(float lo, float hi) { typedef float f2 __attribute__((ext_vector_type(2))); typedef __bf16 b2 __attribute__((ext_vector_type(2))); f2 v = {lo, hi}; b2 b = __builtin_convertvector(v, b2); return __builtin_bit_cast(unsigned, b); }
__device__ __forceinline__ int crow(int r, int hi) { return (r & 3) + 8 * (r >> 2) + 4 * hi; }
__device__ __forceinline__ int t5_bucket_dev(int rel) {
    const int ret = rel > 0 ? 16 : 0; const int n = rel < 0 ? -rel : rel; const float nf = (float)(n < 1 ? 1 : n);
    int large = 8 + (int)(logf(nf / 8.f) / 2.772588722239781f * 8.f); large = large < 15 ? large : 15;
    return ret + (n < 8 ? n : large);
}
#define ATT_WAIT_BAR(N) asm volatile("s_waitcnt vmcnt(" #N ") lgkmcnt(0)\n\ts_barrier" ::: "memory")
struct Tensors { const bf16* img; bf16* O; const float* csg; unsigned* qctr; const float* consts; const float* table; const float* gsub; };

template <bool FOX> __device__ __forceinline__ void attn_unit(int bh, int qb, const Tensors& T, LAS char* shm, volatile LAS int* uslot, int nxt) {
    const int tid = tid_opaque(), lane = tid & 63, r32 = lane & 31, hi = lane >> 5; const int wid = __builtin_amdgcn_readfirstlane(tid >> 6);
    const int b = bh >> 3, h = bh & 7, q0 = qb * 256, qw = q0 + wid * 32;
    const bf16* Qs = T.img + (size_t)(FOX ? 0 : 3) * QKV_SEC + ((size_t)bh * SEQ + qw) * 64;
    const char* Kg = (const char*)(T.img + (size_t)(FOX ? 1 : 4) * QKV_SEC + (size_t)bh * 64 * 4096) + wid * 1024 + lane * 16;
    const char* Vg = (const char*)(T.img + (size_t)(FOX ? 2 : 5) * QKV_SEC + (size_t)bh * 64 * 4096) + wid * 1024 + lane * 16;
    const unsigned lds0 = (unsigned)(uintptr_t)shm;
    LAS float* cs = (LAS float*)(shm + L_CS); LAS float* lut = (LAS float*)(shm + L_LUT); LAS float* sb = (LAS float*)(shm + L_SB);
    const int NT = 4 * qb + 4, tl = 4 * qb + (wid >> 1);
    const float Mt = T.consts[FOX ? 0 : 1 + h];
    int t_start = 0, ts_w = 0; float thr2 = 0.f;
    if (FOX) {
        const float* csr = T.csg + (size_t)bh * SEQ; thr2 = 2.f * Mt + 42.f;
        const float csq0 = csr[q0]; const int c_l = lane < 2 * qb ? lane : 0; const float cend = csr[128 * c_l + 127];
        const int cst = __builtin_popcountll(__ballot(lane < 2 * qb && (csq0 - cend >= thr2)));
        t_start = __builtin_amdgcn_readfirstlane(2 * cst);
        for (int s = 64 * t_start + tid; s < q0 + 256; s += 512) cs[s] = csr[s];
    } else {
        if (tid < 256) lut[tid] = T.table[t5_bucket_dev(tid - 192) * 8 + h] * LOG2E - Mt;
    }
    bf16x8 qr[4];
#pragma unroll
    for (int d0 = 0; d0 < 4; ++d0) qr[d0] = *(const bf16x8*)(Qs + (size_t)r32 * 64 + d0 * 16 + hi * 8);
    asm volatile("s_waitcnt vmcnt(0) lgkmcnt(0)\n\ts_barrier" ::: "memory");
    float cq = 0.f;
    if (FOX) { cq = -cs[qw + r32] - Mt;
        const int ti = t_start + lane; const int ti_c = ti < tl ? ti : tl;
        ts_w = __builtin_amdgcn_readfirstlane(t_start + __builtin_popcountll(__ballot(ti < tl && (cs[qw] - cs[64 * ti_c + 63] >= thr2)))); }
    const float cfar = FOX ? 0.f : (T.table[15 * 8 + h] * LOG2E - Mt);
    f32x16 o1[2], o2[2]; o1[0] = f32x16{}; o1[1] = f32x16{}; o2[0] = f32x16{}; o2[1] = f32x16{};
    float l1 = 0.f, l2 = 0.f;
    const lptr shm3 = (lptr)shm;
    const int koff = hi * 1024 + r32 * 16, voff = 8192 + ((lane >> 4) & 1) * 32 + (lane & 3) * 8 + (4 * hi + ((lane & 15) >> 2)) * 64;
#define ATT_DMA(t, slot) do { glds16(Kg + (size_t)(t) * 8192, (unsigned)__builtin_amdgcn_readfirstlane(lds0 + (slot) * SLOTB + wid * 1024)); \
                              glds16(Vg + (size_t)(t) * 8192, (unsigned)__builtin_amdgcn_readfirstlane(lds0 + (slot) * SLOTB + 8192 + wid * 1024)); } while (0)
    ATT_DMA(t_start, 0);
    int slot = 0;
    for (int t = t_start; t < NT; ++t) {
        const int nslot = (slot == NSLOT - 1) ? 0 : slot + 1;
        if (t + 1 < NT) { ATT_DMA(t + 1, nslot); ATT_WAIT_BAR(2); } else { ATT_WAIT_BAR(0); }
        if (t >= ts_w && t <= tl) {
            const lptr kp = shm3 + slot * SLOTB + koff; const lptr vp = shm3 + slot * SLOTB + voff;
            const int k0 = 64 * t;
            u32x4 pw1[4], pw2[4];
            if (FOX) {
                f32x16 p0, p1; f32x16 cqv;
#pragma unroll
                for (int r = 0; r < 16; ++r) cqv[r] = cq;
#pragma unroll
                for (int d0 = 0; d0 < 4; ++d0) { const bf16x8 k0f = *(const LAS bf16x8*)(kp + d0 * 2048), k1f = *(const LAS bf16x8*)(kp + d0 * 2048 + 512);
                    p0 = __builtin_amdgcn_mfma_f32_32x32x16_bf16(k0f, qr[d0], d0 == 0 ? cqv : p0, 0, 0, 0); p1 = __builtin_amdgcn_mfma_f32_32x32x16_bf16(k1f, qr[d0], d0 == 0 ? cqv : p1, 0, 0, 0); }
#pragma unroll
                for (int g = 0; g < 4; ++g) { const f32x4 n0 = *(const LAS f32x4*)(cs + k0 + 8 * g + 4 * hi), n1 = *(const LAS f32x4*)(cs + k0 + 32 + 8 * g + 4 * hi);
#pragma unroll
                    for (int e = 0; e < 4; ++e) { p0[4 * g + e] = __builtin_amdgcn_exp2f(p0[4 * g + e] + n0[e]); p1[4 * g + e] = __builtin_amdgcn_exp2f(p1[4 * g + e] + n1[e]); } }
                if (t == tl) { const int qrel = qw + r32 - k0 - 4 * hi;
#pragma unroll
                    for (int r = 0; r < 16; ++r) { const int kr = (r & 3) + 8 * (r >> 2); if (kr > qrel) p0[r] = 0.f; if (kr + 32 > qrel) p1[r] = 0.f; } }
                float sa = 0.f;
#pragma unroll
                for (int r = 0; r < 16; ++r) sa += p0[r] + p1[r];
                l1 += sa;
#pragma unroll
                for (int i = 0; i < 4; ++i) { pw1[0][i] = cvtpk(p0[2 * i], p0[2 * i + 1]); pw1[1][i] = cvtpk(p0[8 + 2 * i], p0[9 + 2 * i]); pw1[2][i] = cvtpk(p1[2 * i], p1[2 * i + 1]); pw1[3][i] = cvtpk(p1[8 + 2 * i], p1[9 + 2 * i]); }
            } else {
                const bool farT = (k0 <= qw - 154);
                f32x16 init;
#pragma unroll
                for (int r = 0; r < 16; ++r) init[r] = farT ? cfar : 0.f;
#pragma unroll
                for (int mp = 0; mp < 2; ++mp) {
                    f32x16 p0 = init, p1 = init;
#pragma unroll
                    for (int dd = 0; dd < 2; ++dd) { const int d0 = 2 * mp + dd; const bf16x8 k0f = *(const LAS bf16x8*)(kp + d0 * 2048), k1f = *(const LAS bf16x8*)(kp + d0 * 2048 + 512);
                        p0 = __builtin_amdgcn_mfma_f32_32x32x16_bf16(k0f, qr[d0], p0, 0, 0, 0); p1 = __builtin_amdgcn_mfma_f32_32x32x16_bf16(k1f, qr[d0], p1, 0, 0, 0); }
                    if (!farT) { const LAS float* lp = lut + (k0 - qw - r32 + 192 + 4 * hi);
#pragma unroll
                        for (int r = 0; r < 16; ++r) { const int kr = (r & 3) + 8 * (r >> 2); p0[r] += lp[kr]; p1[r] += lp[kr + 32]; } }
                    float sa = 0.f;
#pragma unroll
                    for (int r = 0; r < 16; ++r) { p0[r] = __builtin_amdgcn_exp2f(p0[r]); p1[r] = __builtin_amdgcn_exp2f(p1[r]); sa += p0[r] + p1[r]; }
                    if (mp == 0) { l1 += sa;
#pragma unroll
                        for (int i = 0; i < 4; ++i) { pw1[0][i] = cvtpk(p0[2 * i], p0[2 * i + 1]); pw1[1][i] = cvtpk(p0[8 + 2 * i], p0[9 + 2 * i]); pw1[2][i] = cvtpk(p1[2 * i], p1[2 * i + 1]); pw1[3][i] = cvtpk(p1[8 + 2 * i], p1[9 + 2 * i]); }
                    } else { l2 += sa;
#pragma unroll
                        for (int i = 0; i < 4; ++i) { pw2[0][i] = cvtpk(p0[2 * i], p0[2 * i + 1]); pw2[1][i] = cvtpk(p0[8 + 2 * i], p0[9 + 2 * i]); pw2[2][i] = cvtpk(p1[2 * i], p1[2 * i + 1]); pw2[3][i] = cvtpk(p1[8 + 2 * i], p1[9 + 2 * i]); } }
                }
            }
#pragma unroll
            for (int dh = 0; dh < 2; ++dh)
#pragma unroll
                for (int ks = 0; ks < 4; ++ks) { const s16x4 lo = vtr(vp + dh * 4096 + ks * 1024), hh = vtr(vp + dh * 4096 + ks * 1024 + 512);
                    const bf16x8 vf = (bf16x8){lo[0], lo[1], lo[2], lo[3], hh[0], hh[1], hh[2], hh[3]};
                    o1[dh] = __builtin_amdgcn_mfma_f32_32x32x16_bf16(vf, __builtin_bit_cast(bf16x8, pw1[ks]), o1[dh], 0, 0, 0);
                    if (!FOX) o2[dh] = __builtin_amdgcn_mfma_f32_32x32x16_bf16(vf, __builtin_bit_cast(bf16x8, pw2[ks]), o2[dh], 0, 0, 0); }
        }
        slot = nslot;
    }
    if (tid == 0) *uslot = nxt;
    { auto rr = __builtin_amdgcn_permlane32_swap(__float_as_uint(l1), __float_as_uint(l1), false, false); l1 = __uint_as_float(rr[0]) + __uint_as_float(rr[1]); }
    const float i1 = 1.f / l1;
    if (FOX) {
#pragma unroll
        for (int dh = 0; dh < 2; ++dh)
#pragma unroll
            for (int r = 0; r < 16; ++r) o1[dh][r] *= i1;
    } else {
        { auto rr = __builtin_amdgcn_permlane32_swap(__float_as_uint(l2), __float_as_uint(l2), false, false); l2 = __uint_as_float(rr[0]) + __uint_as_float(rr[1]); }
        const float i2 = T.consts[9] / l2; float ss = 0.f;
#pragma unroll
        for (int dh = 0; dh < 2; ++dh)
#pragma unroll
            for (int r = 0; r < 16; ++r) { const float v = o1[dh][r] * i1 - o2[dh][r] * i2; o1[dh][r] = v; ss += v * v; }
        { auto rr = __builtin_amdgcn_permlane32_swap(__float_as_uint(ss), __float_as_uint(ss), false, false); ss = __uint_as_float(rr[0]) + __uint_as_float(rr[1]); }
        const float rn = __builtin_amdgcn_rsqf(ss * (1.f / 64) + 1e-6f) * 0.8f;
#pragma unroll
        for (int dh = 0; dh < 2; ++dh)
#pragma unroll
            for (int g = 0; g < 4; ++g) { const f32x4 gs = *(const f32x4*)(T.gsub + 32 * dh + 8 * g + 4 * hi);
#pragma unroll
                for (int e = 0; e < 4; ++e) o1[dh][4 * g + e] *= rn * gs[e]; }
    }
    LAS char* ost = shm + L_OST + wid * (32 * OST_ROW);
#pragma unroll
    for (int dh = 0; dh < 2; ++dh)
#pragma unroll
        for (int g = 0; g < 4; ++g) { u32x2 w; w.x = cvtpk(o1[dh][4 * g], o1[dh][4 * g + 1]); w.y = cvtpk(o1[dh][4 * g + 2], o1[dh][4 * g + 3]);
            *(LAS u32x2*)(ost + r32 * OST_ROW + (32 * dh + 8 * g + 4 * hi) * 2) = w; }
    asm volatile("s_waitcnt lgkmcnt(0)" ::: "memory");
    bf16* Ow = T.O + ((size_t)b * SEQ + qw) * DM + (FOX ? 0 : 512) + h * 64;
#pragma unroll
    for (int i = 0; i < 4; ++i) { const int row = i * 8 + (lane >> 3), ch = lane & 7; const u32x4 v = *(const LAS u32x4*)(ost + row * OST_ROW + ch * 16); *(u32x4*)(Ow + (size_t)row * DM + ch * 8) = v; }
    asm volatile("s_waitcnt lgkmcnt(0)\n\ts_barrier" ::: "memory");
#undef ATT_DMA
}
__device__ __forceinline__ void attn_phase(const Tensors& T, LAS char* shm) {
    const int tid = tid_opaque(); volatile LAS int* uslot = (volatile LAS int*)(shm + L_END);
    if (tid == 0) *uslot = (int)__hip_atomic_fetch_add(T.qctr, 1u, __ATOMIC_RELAXED, __HIP_MEMORY_SCOPE_AGENT);
    asm volatile("s_waitcnt vmcnt(0) lgkmcnt(0)\n\ts_barrier" ::: "memory");
    int u = __builtin_amdgcn_readfirstlane(*uslot);
    while (u < 2048) {
        int nxt = 0; if (tid == 0) nxt = (int)__hip_atomic_fetch_add(T.qctr, 1u, __ATOMIC_RELAXED, __HIP_MEMORY_SCOPE_AGENT);
        const int r = u & 1023, qb = 15 - (r >> 6), bh = r & 63;
        if (u < 1024) attn_unit<false>(bh, qb, T, shm, uslot, nxt); else attn_unit<true>(bh, qb, T, shm, uslot, nxt);
        u = __builtin_amdgcn_readfirstlane(*uslot);
    }
}
#undef ATT_WAIT_BAR
}

namespace peers {
typedef unsigned u32x4 __attribute__((ext_vector_type(4)));
typedef unsigned u32x2 __attribute__((ext_vector_type(2)));
typedef float f32x4 __attribute__((ext_vector_type(4)));
typedef float f2_t __attribute__((ext_vector_type(2)));
template <int CTRL> __device__ __forceinline__ float dpp(float x) { return __builtin_bit_cast(float, __builtin_amdgcn_mov_dpp(__builtin_bit_cast(int, x), CTRL, 0xf, 0xf, true)); }
__device__ __forceinline__ float gelu_as(float v) {
    const float av = fabsf(v), t = __builtin_amdgcn_rcpf(av * 0.2316418882f + 1.0f);
    float q = t * 0.5307027145f + (-0.7265760135f); q = q * t + 0.7107068705f; q = q * t + (-0.142248368f); q = q * t + 0.127414796f; q = q * t;
    const float e = __builtin_amdgcn_exp2f(v * v * (-0.72134752044f)), m = v * (q * e);
    return v < 0.f ? m : v - m;
}
struct SArgs { float* H; const bf16* xb; const float* rowpart; const int* idx; const float* gw; const unsigned char* T8in; const unsigned char* T8out; const float* sin_; const float* sout_;
               const float* plen; bf16* xn2; float* zpart; float* act; float* r2part; const unsigned char* x8; const float* sx; unsigned short* actq; float* sact; const float* rstdv; float* ssum; unsigned char* h8; };
__device__ __forceinline__ void gx_phase(const bf16* xb, unsigned char* xq, float* sx, const float* rowpart, float* rstdv) {
    const int tid = tid_opaque(), lane = tid & 63, wave = tid >> 6; const int S = gridDim.x * 8;
#pragma unroll 1
    for (int tb = blockIdx.x * 8 + wave; tb < TOK; tb += 4 * S) {
        u32x4 wv[4][2];
#pragma unroll
        for (int q = 0; q < 4; ++q) { const int t = tb + q * S; if (t < TOK) { wv[q][0] = *(const u32x4*)(xb + (size_t)t * DM + lane * 16); wv[q][1] = *(const u32x4*)(xb + (size_t)t * DM + lane * 16 + 8); } }
#pragma unroll
        for (int q = 0; q < 4; ++q) { const int t = tb + q * S; if (t < TOK) {
            float xf[16];
#pragma unroll
            for (int hlf = 0; hlf < 2; ++hlf) { const u32x4 w = wv[q][hlf];
                xf[hlf * 8 + 0] = __builtin_bit_cast(float, w.x << 16); xf[hlf * 8 + 1] = __builtin_bit_cast(float, w.x & 0xffff0000u); xf[hlf * 8 + 2] = __builtin_bit_cast(float, w.y << 16); xf[hlf * 8 + 3] = __builtin_bit_cast(float, w.y & 0xffff0000u);
                xf[hlf * 8 + 4] = __builtin_bit_cast(float, w.z << 16); xf[hlf * 8 + 5] = __builtin_bit_cast(float, w.z & 0xffff0000u); xf[hlf * 8 + 6] = __builtin_bit_cast(float, w.w << 16); xf[hlf * 8 + 7] = __builtin_bit_cast(float, w.w & 0xffff0000u); }
            float mx = 0.f;
#pragma unroll
            for (int k = 0; k < 16; ++k) mx = fmaxf(mx, fabsf(xf[k]));
            mx = fmaxf(mx, dpp<0xB1>(mx)); mx = fmaxf(mx, dpp<0x4E>(mx)); mx = fmaxf(mx, dpp<0x141>(mx)); mx = fmaxf(mx, dpp<0x140>(mx));
            const float sc = mx > 0.f ? mx * (1.f / 119.f) : 1.f, inv = 1.f / sc; unsigned xh[2] = {0u, 0u}, xl[2] = {0u, 0u};
#pragma unroll
            for (int k = 0; k < 16; ++k) { int xi = __float2int_rn(xf[k] * inv); xi = xi < -120 ? -120 : (xi > 119 ? 119 : xi); const int lo = ((xi + 8) & 15) - 8, hi = (xi - lo) >> 4;
                xh[k >> 3] |= (unsigned)(hi & 15) << (4 * (k & 7)); xl[k >> 3] |= (unsigned)(lo & 15) << (4 * (k & 7)); }
            { unsigned char* blk = xq + (size_t)t * 1024 + (lane >> 1) * 32 + (lane & 1) * 8; u32x2 oh, ol; oh.x = xh[0]; oh.y = xh[1]; ol.x = xl[0]; ol.y = xl[1];
              *(u32x2*)blk = oh; *(u32x2*)(blk + 16) = ol; }
            if ((lane & 15) == 0) sx[(size_t)t * 4 + (lane >> 4)] = sc;
            if (lane == 0) rstdv[t] = pg8::row_rstd(rowpart, t); } }
    }
}
__device__ __forceinline__ void ga_phase(const SArgs& A, LAS char* shm) {
    const int tid = tid_opaque(), lane = tid & 63, wave = tid >> 6, g8 = lane >> 3, i8 = lane & 7;
    const int s = blockIdx.x & 7, sl = s & 3, half = s >> 2, nw = (gridDim.x >> 3) * 8;
    LAS int* sidx = (LAS int*)(shm + wave * 1024); LAS float* zst = (LAS float*)(sidx + 128);
    const unsigned char* Tb = A.T8in + (size_t)sl * 16384 * 128 + i8 * 16;
    const unsigned char* xq = A.x8 + sl * 256 + i8 * 32;
    u32x4 rbA[16], rbB[16], xhA, xlA, xhB, xlB; float sxA, sxB; int ia, ib;
#define GA_FETCH(tt) do { ia = A.idx[(size_t)(tt) * 128 + lane]; ib = A.idx[(size_t)(tt) * 128 + 64 + lane]; } while (0)
#define GA_ISSUE(RB, XH, XL, SX, tt) do { sidx[lane] = ia; sidx[lane + 64] = ib; XH = *(const u32x4*)(xq + (size_t)(tt) * 1024); XL = *(const u32x4*)(xq + (size_t)(tt) * 1024 + 16); SX = A.sx[(size_t)(tt) * 4 + sl]; \
        _Pragma("unroll") for (int r = 0; r < 16; ++r) { const unsigned e = (unsigned)sidx[8 * r + g8]; RB[r] = *(const u32x4*)(Tb + (e << 7)); } } while (0)
#define GA_COMPUTE(RB, XH, XL, SX, tt) do { int k0v = 0, k1v = 0; \
        _Pragma("unroll") for (int r = 0; r < 16; ++r) { int dh = 0, dl = 0; \
            _Pragma("unroll") for (int j = 0; j < 4; ++j) { dh = __builtin_amdgcn_sdot8((int)RB[r][j], (int)XH[j], dh, false); dl = __builtin_amdgcn_sdot8((int)RB[r][j], (int)XL[j], dl, false); } \
            int d = dh * 16 + dl; \
            d += __builtin_amdgcn_mov_dpp(d, 0xB1, 0xf, 0xf, true); d += __builtin_amdgcn_mov_dpp(d, 0x4E, 0xf, 0xf, true); d += __builtin_amdgcn_mov_dpp(d, 0x141, 0xf, 0xf, true); \
            if (r < 8) k0v = (i8 == r) ? d : k0v; else k1v = (i8 == r - 8) ? d : k1v; } \
        const float z0 = (float)k0v * SX, z1 = (float)k1v * SX, p0 = dpp<0x128>(z0), p1 = dpp<0x128>(z1); \
        const unsigned w_ = (g8 & 1) ? pg8::cvt_pk_bf16(p1, z1) : pg8::cvt_pk_bf16(z0, p0); \
        ((unsigned*)A.zpart)[((size_t)sl * TOK + (tt)) * 64 + ((g8 & 1) ? 32 : 0) + 4 * i8 + (g8 >> 1)] = w_; } while (0)
    const int nw2 = 2 * nw;
    int t0 = (blockIdx.x >> 3) * 8 + wave + half * nw;
    if (t0 < TOK) { GA_FETCH(t0); GA_ISSUE(rbA, xhA, xlA, sxA, t0); }
    int t1 = t0 + nw2; if (t1 < TOK) GA_FETCH(t1);
    while (t0 < TOK) {
        const int t2 = t1 + nw2;
        if (t1 < TOK) { GA_ISSUE(rbB, xhB, xlB, sxB, t1); if (t2 < TOK) GA_FETCH(t2); }
        GA_COMPUTE(rbA, xhA, xlA, sxA, t0);
        if (t1 >= TOK) break;
        const int t3 = t2 + nw2;
        if (t2 < TOK) { GA_ISSUE(rbA, xhA, xlA, sxA, t2); if (t3 < TOK) GA_FETCH(t3); }
        GA_COMPUTE(rbB, xhB, xlB, sxB, t1);
        t0 = t2; t1 = t3;
    }
#undef GA_FETCH
#undef GA_ISSUE
#undef GA_COMPUTE
}
__device__ __forceinline__ void gr_phase(const SArgs& A) {
    const int tid = tid_opaque(), lane = tid & 63, wave = tid >> 6; const int S = gridDim.x * 8;
    typedef int i32x2 __attribute__((ext_vector_type(2)));
#pragma unroll 1
    for (int tb = blockIdx.x * 8 + wave; tb < TOK; tb += 4 * S) {
        unsigned zw[4][4]; f2_t gv[4]; float rs[4], si[4][2], so[4][2]; i32x2 ee[4];
#pragma unroll
        for (int q = 0; q < 4; ++q) { const int t = tb + q * S; if (t < TOK) { rs[q] = A.rstdv[t];
            ee[q] = *(const i32x2*)(A.idx + (size_t)t * 128 + 2 * lane); gv[q] = *(const f2_t*)(A.gw + (size_t)t * 128 + 2 * lane);
#pragma unroll
            for (int s = 0; s < 4; ++s) zw[q][s] = ((const unsigned*)A.zpart)[((size_t)s * TOK + t) * 64 + lane]; } }
#pragma unroll
        for (int q = 0; q < 4; ++q) { const int t = tb + q * S; if (t < TOK) {
            si[q][0] = A.sin_[ee[q].x]; so[q][0] = A.sout_[ee[q].x]; si[q][1] = A.sin_[ee[q].y]; so[q][1] = A.sout_[ee[q].y]; } }
#pragma unroll
        for (int q = 0; q < 4; ++q) { const int t = tb + q * S; if (t < TOK) { float z0 = 0.f, z1 = 0.f;
#pragma unroll
            for (int s = 0; s < 4; ++s) { z0 += __builtin_bit_cast(float, zw[q][s] << 16); z1 += __builtin_bit_cast(float, zw[q][s] & 0xffff0000u); }
            const float a0 = gelu_as(z0 * (si[q][0] * rs[q])) * gv[q].x * so[q][0], a1 = gelu_as(z1 * (si[q][1] * rs[q])) * gv[q].y * so[q][1];
            const float mx = wave_max(fmaxf(fabsf(a0), fabsf(a1)));
            const float sa = mx > 0.f ? mx * (1.f / 127.f) : 1.f, inv = 1.f / sa;
            const int q0 = __float2int_rn(a0 * inv), q1 = __float2int_rn(a1 * inv);
            ((unsigned short*)A.actq)[(size_t)t * 64 + lane] = (unsigned short)((q0 & 0xff) | ((q1 & 0xff) << 8));
            { const float sq_ = wave_sum((float)(q0 + q1)); if (lane == 0) A.ssum[t] = sq_; }
            if (lane == 0) A.sact[t] = sa; } }
    }
}
typedef int i32x4m __attribute__((ext_vector_type(4)));
__device__ __forceinline__ void gb_phase(const SArgs& A, LAS char* shm) {
    const int tid = tid_opaque(), lane = tid & 63, wave = tid >> 6, g8 = lane >> 3, i8 = lane & 7, n = lane & 15, kg = lane >> 4;
    const int s = blockIdx.x & 7, sl = s & 3, half = s >> 2, nw = (gridDim.x >> 3) * 8;
    LAS int* sidx = (LAS int*)(shm + wave * 2048); LAS unsigned* sqA = (LAS unsigned*)(sidx + 128); LAS unsigned* sqB = sqA + 128;
    const unsigned char* Tb = A.T8out + (size_t)sl * 16384 * 128 + i8 * 16;
    const unsigned bm = 0xffu << (8u * (n & 3)), m0 = (n >> 2) == 0 ? bm : 0u, m1 = (n >> 2) == 1 ? bm : 0u, m2 = (n >> 2) == 2 ? bm : 0u, m3 = (n >> 2) == 3 ? bm : 0u;
    const int jb = (kg >> 1) * 2, cA = sl * 256 + 32 * (4 * (kg & 1) + jb) + 8 * (n >> 2) + 2 * (n & 3), cB = cA + 32;
    u32x4 rbA[16], rbB[16]; unsigned hA0, hA1, hB0, hB1; float saA, saB, ssA, ssB; int ia, ib; unsigned aqw;
#define GB_FETCH(tt) do { ia = A.idx[(size_t)(tt) * 128 + lane]; ib = A.idx[(size_t)(tt) * 128 + 64 + lane]; aqw = ((const unsigned short*)A.actq)[(size_t)(tt) * 64 + lane]; } while (0)
#define GB_ISSUE(RB, SQ, H0, H1, SA, SS, tt) do { sidx[lane] = ia; sidx[lane + 64] = ib; { u32x2 rep_; rep_.x = (aqw & 0xffu) * 0x01010101u; rep_.y = (aqw >> 8) * 0x01010101u; *(LAS u32x2*)((SQ) + 2 * lane) = rep_; } SA = A.sact[tt]; SS = A.ssum[tt]; \
        H0 = *(const unsigned*)(A.xn2 + (size_t)(tt) * DM + cA); H1 = *(const unsigned*)(A.xn2 + (size_t)(tt) * DM + cB); \
        _Pragma("unroll") for (int r = 0; r < 16; ++r) { const unsigned e = (unsigned)sidx[8 * r + g8]; RB[r] = *(const u32x4*)(Tb + (e << 7)); } } while (0)
#define GB_COMPUTE(RB, SQ, H0, H1, SA, SS, tt) do { i32x4m de1 = {0, 0, 0, 0}, de2 = de1, do1 = de1, do2 = de1; \
        _Pragma("unroll") for (int r = 0; r < 16; ++r) { const u32x2 aq2 = *(const LAS u32x2*)((SQ) + 8 * r + 2 * kg); const unsigned te = aq2.x, to = aq2.y; \
            const i32x4m be = {(int)(te & m0), (int)(te & m1), (int)(te & m2), (int)(te & m3)}, bo = {(int)(to & m0), (int)(to & m1), (int)(to & m2), (int)(to & m3)}; \
            const i32x4m a1 = {(int)(RB[r].x & 0x0F0F0F0Fu), (int)(RB[r].y & 0x0F0F0F0Fu), (int)(RB[r].z & 0x0F0F0F0Fu), (int)(RB[r].w & 0x0F0F0F0Fu)};     \
            const i32x4m a2 = {(int)RB[r].x, (int)RB[r].y, (int)RB[r].z, (int)RB[r].w};     \
            de1 = __builtin_amdgcn_mfma_i32_16x16x64_i8(a1, be, de1, 0, 0, 0); de2 = __builtin_amdgcn_mfma_i32_16x16x64_i8(a2, be, de2, 0, 0, 0); \
            do1 = __builtin_amdgcn_mfma_i32_16x16x64_i8(a1, bo, do1, 0, 0, 0); do2 = __builtin_amdgcn_mfma_i32_16x16x64_i8(a2, bo, do2, 0, 0, 0); } \
        int v1[4], v2[4]; \
        _Pragma("unroll") for (int j = 0; j < 4; ++j) { const int x1 = kg < 2 ? de1[j] : do1[j], x2 = kg < 2 ? de2[j] : do2[j]; \
            { auto rr = __builtin_amdgcn_permlane32_swap((unsigned)x1, (unsigned)x1, false, false); v1[j] = (int)rr[0] + (int)rr[1]; } \
            { auto rr = __builtin_amdgcn_permlane32_swap((unsigned)x2, (unsigned)x2, false, false); v2[j] = (int)rr[0] + (int)rr[1]; } } \
        const float sc_ = SA * (1.f / 16.f), off_ = 8.f * SS; \
        const float oA0 = ((float)(kg < 2 ? v1[0] : v1[2]) - off_) * SA, oA1 = (float)(kg < 2 ? v2[0] - v1[0] : v2[2] - v1[2]) * sc_, oB0 = ((float)(kg < 2 ? v1[1] : v1[3]) - off_) * SA, oB1 = (float)(kg < 2 ? v2[1] - v1[1] : v2[3] - v1[3]) * sc_; \
        const float nA0 = __builtin_bit_cast(float, H0 << 16) + oA0, nA1 = __builtin_bit_cast(float, H0 & 0xffff0000u) + oA1, nB0 = __builtin_bit_cast(float, H1 << 16) + oB0, nB1 = __builtin_bit_cast(float, H1 & 0xffff0000u) + oB1; \
        *(unsigned*)(A.xn2 + (size_t)(tt) * DM + cA) = pg8::cvt_pk_bf16(nA0, nA1); *(unsigned*)(A.xn2 + (size_t)(tt) * DM + cB) = pg8::cvt_pk_bf16(nB0, nB1); \
        { const int p8 = __builtin_amdgcn_cvt_pk_fp8_f32(nB0, nB1, __builtin_amdgcn_cvt_pk_fp8_f32(nA0, nA1, 0, false), true);     \
          *(unsigned short*)(A.h8 + (size_t)(tt) * DM + cA) = (unsigned short)(p8 & 0xffff); *(unsigned short*)(A.h8 + (size_t)(tt) * DM + cB) = (unsigned short)((unsigned)p8 >> 16); } \
        const float ss = wave_sum((nA0 * nA0 + nA1 * nA1) + (nB0 * nB0 + nB1 * nB1)); if (lane == 0) A.r2part[(size_t)(tt) * 4 + sl] = ss; } while (0)
    const int nw2 = 2 * nw;
    int t0 = (blockIdx.x >> 3) * 8 + wave + half * nw;
    if (t0 < TOK) { GB_FETCH(t0); GB_ISSUE(rbA, sqA, hA0, hA1, saA, ssA, t0); }
    int t1 = t0 + nw2; if (t1 < TOK) GB_FETCH(t1);
    while (t0 < TOK) {
        const int t2 = t1 + nw2;
        if (t1 < TOK) { GB_ISSUE(rbB, sqB, hB0, hB1, saB, ssB, t1); if (t2 < TOK) GB_FETCH(t2); }
        GB_COMPUTE(rbA, sqA, hA0, hA1, saA, ssA, t0);
        if (t1 >= TOK) break;
        const int t3 = t2 + nw2;
        if (t2 < TOK) { GB_ISSUE(rbA, sqA, hA0, hA1, saA, ssA, t2); if (t3 < TOK) GB_FETCH(t3); }
        GB_COMPUTE(rbB, sqB, hB0, hB1, saB, ssB, t1);
        t0 = t2; t1 = t3;
    }
#undef GB_FETCH
#undef GB_ISSUE
#undef GB_COMPUTE
}
}

namespace route {
typedef short bf16x8 __attribute__((ext_vector_type(8)));
typedef float f32x16 __attribute__((ext_vector_type(16)));
typedef unsigned u32x4 __attribute__((ext_vector_type(4)));
__device__ __forceinline__ int imax(int a, int b) { return a > b ? a : b; }
__device__ __forceinline__ int imin(int a, int b) { return a < b ? a : b; }
__device__ __forceinline__ int f2key(float f) { const int b = __builtin_bit_cast(int, f); return b ^ ((b >> 31) & 0x7fffffff); }
__device__ __forceinline__ float key2f(int k) { return __builtin_bit_cast(float, k ^ ((k >> 31) & 0x7fffffff)); }
__device__ __forceinline__ void sort16_desc(int (&a)[16]) {
#pragma unroll
    for (int k = 2; k <= 16; k <<= 1)
#pragma unroll
        for (int j = k >> 1; j > 0; j >>= 1)
#pragma unroll
            for (int i = 0; i < 16; ++i) { const int l = i ^ j; if (l > i) { const bool desc = ((i & k) == 0); const int hi = imax(a[i], a[l]), lo = imin(a[i], a[l]); a[i] = desc ? hi : lo; a[l] = desc ? lo : hi; } }
}
__device__ __forceinline__ void merge_top16(int (&a)[16], const int (&b)[16]) {
#pragma unroll
    for (int i = 0; i < 16; ++i) a[i] = imax(a[i], b[15 - i]);
#pragma unroll
    for (int j = 8; j > 0; j >>= 1)
#pragma unroll
        for (int i = 0; i < 16; ++i) { const int l = i ^ j; if (l > i) { const int hi = imax(a[i], a[l]), lo = imin(a[i], a[l]); a[i] = hi; a[l] = lo; } }
}
__device__ __forceinline__ void merge_partner(int (&a)[16]) {
    int p[16];
#pragma unroll
    for (int i = 0; i < 16; ++i) p[i] = __shfl_xor(a[i], 32);
    merge_top16(a, p);
}
__device__ constexpr int CA[27] = {0,0,0,0,0,0,0,0,0,0,0,0,0,0,0, 1,1,1,1,1,1, 2,2, 0,1,2,3};
__device__ constexpr int CB[27] = {1,2,3,4,5,6,7,8,9,10,11,12,13,14,15, 2,3,4,5,6,7, 3,4, 0,1,2,3};
struct RArgs { const bf16* q; const bf16* skb; int* idx; float* gw; };
__device__ __forceinline__ void route_phase(const RArgs& A, LAS char* shm) {
    const int tid = tid_opaque(), lane = tid & 63, wave = tid >> 6, r32 = lane & 31, hh = lane >> 5;
    LAS char* wreg = shm + wave * 8704;
    LAS int* tab = (LAS int*)wreg + lane * 33;
    const int h = blockIdx.x & 7, ntg = gridDim.x >> 3;
    LAS char* skl = shm + 8 * 8704;
    { const char* src = (const char*)A.skb + (size_t)h * 65536;
#pragma unroll
      for (int ps = 0; ps < 8; ++ps) { const int ci = ps * 512 + tid; *(LAS u32x4*)(skl + (ci >> 4) * 272 + (ci & 15) * 16) = *(const u32x4*)(src + (size_t)ci * 16); } }
    __syncthreads();
    for (int tile = (blockIdx.x >> 3) + ntg * wave; tile < TOK / 32; tile += ntg * 8) {
        const int tok = tile * 32 + r32;
        const char* q_c = (const char*)A.q; unsigned lpart = (unsigned)(r32 * 256 + hh * 16); asm volatile("" : "+v"(lpart));
        const unsigned qoff = (unsigned)(tile * 32) * 4096u + lpart * 16u - (unsigned)(hh * 16) * 15u + (unsigned)(h * 512);
        int hh_l = hh; asm volatile("" : "+v"(hh_l));
        int top[2][16];
#pragma unroll
        for (int c = 0; c < 2; ++c) {
            bf16x8 qf[8];
            { u32x4 qs[8];
#pragma unroll
              for (int j = 0; j < 8; ++j) qs[j] = *(const u32x4*)(q_c + ((unsigned)(tile * 32 + 4 * j + (lane >> 4)) * 4096u + (unsigned)(h * 512 + c * 256 + (lane & 15) * 16)));
#pragma unroll
              for (int j = 0; j < 8; ++j) *(LAS u32x4*)(wreg + (4 * j + (lane >> 4)) * 272 + (lane & 15) * 16) = qs[j]; }
#pragma unroll
            for (int ks = 0; ks < 8; ++ks) qf[ks] = *(const LAS bf16x8*)(wreg + r32 * 272 + ks * 32 + hh * 16);
            int kk[4][16];
#pragma unroll
            for (int kb = 0; kb < 4; ++kb) { f32x16 acc = f32x16{};
                const LAS char* sp = skl + (c * 128 + kb * 32 + r32) * 272 + hh * 16;
#pragma unroll
                for (int ks = 0; ks < 8; ++ks) acc = __builtin_amdgcn_mfma_f32_32x32x16_bf16(*(const LAS bf16x8*)(sp + ks * 32), qf[ks], acc, 0, 0, 0);
#pragma unroll
                for (int r = 0; r < 16; ++r) kk[kb][r] = (f2key(acc[r]) & ~127) | (kb * 32 + (r & 3) + 8 * (r >> 2)); }
#pragma unroll
            for (int kb = 0; kb < 4; ++kb) sort16_desc(kk[kb]);
            merge_top16(kk[0], kk[1]); merge_top16(kk[2], kk[3]); merge_top16(kk[0], kk[2]);
#pragma unroll
            for (int i = 0; i < 16; ++i) kk[0][i] |= hh << 2;
            merge_partner(kk[0]);
#pragma unroll
            for (int i = 0; i < 16; ++i) top[c][i] = kk[0][i];
        }
#pragma unroll
        for (int i = 0; i < 16; ++i) { tab[i] = top[0][i] & 127; tab[16 + i] = top[1][i] & 127; }
        float s0[16], s1[16];
#pragma unroll
        for (int i = 0; i < 16; ++i) { const float a = key2f(top[0][i] & ~127), b = key2f(top[1][i] & ~127); s0[i] = hh ? b : a; s1[i] = hh ? a : b; }
        int c0[16], c1[16];
#pragma unroll
        for (int k = 0; k < 32; ++k) { int key;
            if (k < 27) { const float sum = s0[CA[k]] + s1[CB[k]]; const int code0 = (CA[k] << 4) | CB[k], code1 = (CB[k] << 4) | CA[k];
                key = (f2key(sum) & ~255) | (hh_l ? code1 : code0); if (k >= 23 && hh_l) key = (int)0x80000000; }
            else key = (int)0x80000000;
            if (k < 16) c0[k] = key; else c1[k - 16] = key; }
        sort16_desc(c0); sort16_desc(c1); merge_top16(c0, c1); merge_partner(c0);
        float e[16]; const float m = key2f(c0[0] & ~255); float sum = 0.f;
#pragma unroll
        for (int k = 0; k < 16; ++k) { e[k] = __expf(key2f(c0[k] & ~255) - m); sum += e[k]; }
        const float inv = 1.f / sum; unsigned ov[16];
#pragma unroll
        for (int k = 0; k < 16; ++k) { const int a = (c0[k] >> 4) & 15, b = c0[k] & 15; const int ex = tab[a] * 128 + tab[16 + b]; ov[k] = hh ? __float_as_uint(e[k] * inv) : (unsigned)ex; }
        unsigned* dst = hh ? (unsigned*)(A.gw + (size_t)tok * 128 + h * 16) : (unsigned*)(A.idx + (size_t)tok * 128 + h * 16);
#pragma unroll
        for (int k = 0; k < 4; ++k) { u32x4 w; w.x = ov[4 * k]; w.y = ov[4 * k + 1]; w.z = ov[4 * k + 2]; w.w = ov[4 * k + 3]; ((u32x4*)dst)[k] = w; }
    }
}
}
#define XB_TMO      128
#define XB_XCNT(j)  (256  + 64 * (j))
#define XB_XSUB(j)  (1280 + 64 * (j))
#define XB_XGEN(j)  (2304 + 64 * (j))
#define XB_TOP      3328
#define XB_TOPGEN   3392
#define XCD_BAR_WORDS 3456
#define XB_SPIN_CAP (1u << 18)

__device__ __forceinline__ unsigned xb_ld(unsigned* p)              { return __hip_atomic_load(p, __ATOMIC_RELAXED, __HIP_MEMORY_SCOPE_AGENT); }
__device__ __forceinline__ unsigned xb_add(unsigned* p, unsigned v) { return __hip_atomic_fetch_add(p, v, __ATOMIC_RELAXED, __HIP_MEMORY_SCOPE_AGENT); }
__device__ __forceinline__ unsigned xb_xcc_id() { return (unsigned)__builtin_amdgcn_s_getreg((3 << 11) | 20) & 0xFu; }
#define XB_SPIN(cond, bar) do { unsigned _sp = 0; while (cond) { __builtin_amdgcn_s_sleep(1); \
    if ((++_sp & 255u) == 0u) { if (xb_ld(&(bar)[XB_TMO])) break; if (_sp > XB_SPIN_CAP) { atomicAdd(&(bar)[XB_TMO], 1u); break; } } } } while (0)

struct XcdBarrier {
    unsigned* bar; unsigned x;
    volatile LAS unsigned* st;
};

__device__ __forceinline__ XcdBarrier xcd_barrier_post(unsigned* bar, volatile LAS unsigned* st) {
    XcdBarrier b; b.bar = bar; b.x = xb_xcc_id(); b.st = st;
    if (threadIdx.x == 0) (void)xb_add(&bar[XB_XCNT(b.x)], 1u);
    return b;
}
__device__ __forceinline__ void xcd_barrier_complete(unsigned* bar, unsigned x, unsigned& nloc, unsigned& nx) {
    const unsigned G = gridDim.x * gridDim.y * gridDim.z;
    unsigned sum, cnt, mine, sp = 0u;
    for (;;) {
        sum = 0u; cnt = 0u; mine = 0u;
#pragma unroll
        for (unsigned j = 0; j < 16; ++j) { const unsigned c = xb_ld(&bar[XB_XCNT(j)]); sum += c; cnt += (c > 0u) ? 1u : 0u; mine = (j == x) ? c : mine; }
        if (sum == G) break;
        __builtin_amdgcn_s_sleep(1);
        if ((++sp & 255u) == 0u) { if (xb_ld(&bar[XB_TMO])) break; if (sp > XB_SPIN_CAP) { atomicAdd(&bar[XB_TMO], 1u); break; } }
    }
    nloc = mine > 0u ? mine : 1u; nx = cnt > 0u ? cnt : 1u;
}

__device__ __forceinline__ void xcd_barrier(const XcdBarrier& b) {
    asm volatile("s_waitcnt vmcnt(0)" ::: "memory");
    __syncthreads();
    if (threadIdx.x == 0) {
        unsigned* bar = b.bar;
        __builtin_amdgcn_s_waitcnt(0);
        unsigned nloc = b.st[0], nx = b.st[1];
        if (nloc == 0u) { xcd_barrier_complete(bar, b.x, nloc, nx); b.st[0] = nloc; b.st[1] = nx; }
        const unsigned old = xb_add(&bar[XB_XSUB(b.x)], 1u);
        const unsigned gen = old / nloc;
        if (old + 1u == (gen + 1u) * nloc) {
            __builtin_amdgcn_fence(__ATOMIC_RELEASE, "agent");
            asm volatile("s_waitcnt vmcnt(0)" ::: "memory");
            __hip_atomic_fetch_add(&bar[XB_TOPGEN], 1u, __ATOMIC_RELAXED, __HIP_MEMORY_SCOPE_AGENT);
        }
        __builtin_amdgcn_fence(__ATOMIC_ACQUIRE, "agent");
        { const unsigned tgt = (gen + 1u) * nx; XB_SPIN(xb_ld(&bar[XB_TOPGEN]) < tgt, bar); }
        asm volatile("s_waitcnt vmcnt(0)" ::: "memory");
    }
    __syncthreads();
}

__device__ __forceinline__ void xcd_arrive(const XcdBarrier& b) {
    asm volatile("s_waitcnt vmcnt(0)" ::: "memory");
    __syncthreads();
    if (threadIdx.x == 0) {
        unsigned* bar = b.bar;
        __builtin_amdgcn_s_waitcnt(0);
        unsigned nloc = b.st[0], nx = b.st[1];
        if (nloc == 0u) { xcd_barrier_complete(bar, b.x, nloc, nx); b.st[0] = nloc; b.st[1] = nx; }
        const unsigned old = xb_add(&bar[XB_XSUB(b.x)], 1u);
        const unsigned gen = old / nloc;
        if (old + 1u == (gen + 1u) * nloc) {
            __builtin_amdgcn_fence(__ATOMIC_RELEASE, "agent");
            asm volatile("s_waitcnt vmcnt(0)" ::: "memory");
            __hip_atomic_fetch_add(&bar[XB_TOPGEN], 1u, __ATOMIC_RELAXED, __HIP_MEMORY_SCOPE_AGENT);
        }
        __builtin_amdgcn_fence(__ATOMIC_ACQUIRE, "agent");
        asm volatile("s_waitcnt vmcnt(0)" ::: "memory");
        b.st[2] = (gen + 1u) * nx;
    }
}
__device__ __forceinline__ void xcd_wait(const XcdBarrier& b) {
    asm volatile("s_waitcnt vmcnt(0)" ::: "memory");
    if (threadIdx.x == 0) { unsigned* bar = b.bar; const unsigned tgt = b.st[2]; XB_SPIN(xb_ld(&bar[XB_TOPGEN]) < tgt, bar); }
    __syncthreads();
}

namespace cg = cooperative_groups;
constexpr int LDS_BYTES = 147456;
constexpr size_t WS_CTL = 6 * MiB + 512 * 1024, WS_IMG = 80 * MiB, WS_SKB = 15 * MiB + 512 * 1024, WS_PBF2 = 272 * MiB;
struct Params { const float* in[24]; float* out; unsigned char* ws; long never; };
__global__ void __launch_bounds__(512, 2) mega(Params P) {
    extern __shared__ __attribute__((aligned(16))) unsigned char lds[];
    const float* x = P.in[0]; const float* p = P.in[1]; const float* mix_norm = P.in[2]; const float* w_in = P.in[3];
    const float* b_f = P.in[4]; const float* gfq = P.in[5]; const float* gfk = P.in[6]; const float* gdq = P.in[7]; const float* gdk = P.in[8];
    const float* lq1 = P.in[9]; const float* lk1 = P.in[10]; const float* lq2 = P.in[11]; const float* lk2 = P.in[12];
    const float* gsub = P.in[13]; const float* table = P.in[14]; const float* w_out = P.in[15]; const float* peer_norm = P.in[16];
    const float* w_query = P.in[17]; const float* sub_keys = P.in[18]; const float* e_in = P.in[19]; const float* e_out = P.in[20];
    const float* ple_norm = P.in[21]; const float* w_gate = P.in[22]; const float* w_ple = P.in[23];
    unsigned char* ws = P.ws; float* out = P.out;
    bf16* wt_in = (bf16*)(ws + WS_WT_IN); bf16* wt_out = (bf16*)(ws + WS_WT_OUT); bf16* wt_q = (bf16*)(ws + WS_WT_Q); bf16* wt_gate = (bf16*)(ws + WS_WT_GATE); bf16* wt_ple = (bf16*)(ws + WS_WT_PLE);
    bf16* xn = (bf16*)(ws + WS_XN); bf16* proj = (bf16*)(ws + WS_PROJ); bf16* O = (bf16*)(ws + WS_O); float* gate = (float*)(ws + WS_GATE); bf16* qkv = (bf16*)(ws + WS_QKV);
    bf16* qb = (bf16*)(ws + WS_Q); float* ple = (float*)(ws + WS_PLE); bf16* pbf = (bf16*)(ws + WS_PBF); int* idx = (int*)(ws + WS_IDX); float* gw = (float*)(ws + WS_G);
    float* logf = out;
    PG8_LAS unsigned char* l3 = (PG8_LAS unsigned char*)lds;
    unsigned* barw = (unsigned*)(ws + WS_CTL);
    if (threadIdx.x < 16) ((LAS unsigned*)(lds + LDS_BYTES - 64))[threadIdx.x] = 0u;
    __syncthreads();
    XcdBarrier xbar = xcd_barrier_post(barw, (volatile LAS unsigned*)(lds + LDS_BYTES - 64));
#define GRID_BAR() xcd_barrier(xbar)
#define GEMM_PHASE(EPI, A_, Bt_, M_, N_, K_, E_) do { pg8::Gemm g_{A_, Bt_, M_, N_, K_, 0}; pg8::StaticOrder S_; S_.init(M_, N_, (int)gridDim.x, (int)blockIdx.x); \
        pg8::gemm_phase<EPI, pg8::StaticOrder, true, true>(l3, g_, S_, E_); } while (0)
    bf16* img = (bf16*)(ws + WS_IMG); bf16* skb = (bf16*)(ws + WS_SKB); float* cloc = out + 2 * 262144; float* ttot = out + 4 * 262144; float* gains = out + 5 * 262144; float* consts = gains + 256;
    pbf = (bf16*)(ws + WS_PBF2); unsigned char* ein8 = ws + 416 * MiB; unsigned char* eout8 = ws + 432 * MiB; float* sc_in = (float*)(ws + 448 * MiB); float* sc_out = sc_in + 16384;
#define MAKE_P0ARGS(name) P0Args name{x, p, mix_norm, w_in, b_f, w_out, w_query, sub_keys, e_in, e_out, w_gate, w_ple, wt_in, wt_out, wt_q, wt_gate, wt_ple, skb, ein8, eout8, sc_in, sc_out, pbf, xn, cloc, ttot, gfq, gfk, gdq, gdk, gains, lq1, lk1, lq2, lk2, table, consts, peer_norm, ple_norm}
    { MAKE_P0ARGS(A);
      ph_p0(A, lds, 1 | 8); }
    if (P.never) cg::this_grid().sync();
    xcd_arrive(xbar); { MAKE_P0ARGS(A); ph_p0(A, lds, 16 | 2); } xcd_wait(xbar);
    float* csg = out + 8 * 262144;
    for (int j = blockIdx.x; j < 256; j += gridDim.x) { const int bh = j >> 2, b = bh >> 3, h = bh & 7; float* sbp = (float*)lds;
        __syncthreads();
        if (threadIdx.x < 32) { float a = 0.f; for (int c = 0; c < (int)threadIdx.x; ++c) a += ttot[(b * 32 + c) * 8 + h]; sbp[threadIdx.x] = a; }
        __syncthreads();
        for (int s = (j & 3) * 1024 + threadIdx.x; s < (j & 3) * 1024 + 1024; s += 512) csg[(size_t)bh * SEQ + s] = -1.4426950408889634f * (sbp[s >> 7] + cloc[((size_t)b * SEQ + s) * 8 + h]); }
    __syncthreads();
    { pg8::EpiQKV E{img, gains}; GEMM_PHASE(pg8::EpiQKV, xn, wt_in, TOK, 3072, DM, E); }
    xcd_arrive(xbar); { MAKE_P0ARGS(A); ph_p0(A, lds, 4, 0); } xcd_wait(xbar);
    { O = (bf16*)(ws + 288 * MiB); att::Tensors AT{img, O, csg, barw + XCD_BAR_WORDS + 64, consts, table, gsub}; att::attn_phase(AT, (LAS char*)lds); }
    xcd_arrive(xbar); { MAKE_P0ARGS(A); ph_p0(A, lds, 4, 1); } xcd_wait(xbar);
    float* rowpart = (float*)(ws + 80 * MiB); float* r2part = (float*)(ws + 82 * MiB); bf16* ple_b = (bf16*)(ws + 176 * MiB);
    { pg8::EpiResNorm E{x, xn, rowpart}; GEMM_PHASE(pg8::EpiResNorm, O, wt_out, TOK, DM, DM, E); }
    xcd_arrive(xbar); { MAKE_P0ARGS(A); ph_p0(A, lds, 64); } xcd_wait(xbar);
    { pg8::EpiBf16Row E{qb, rowpart, 2048, 0}; GEMM_PHASE(pg8::EpiBf16Row, xn, wt_q, TOK, 2048, DM, E); }
    unsigned char* x8 = ws + 112 * MiB; float* sxq = (float*)(ws + 84 * MiB); float* rstdv = (float*)(ws + 87 * MiB);
    xcd_arrive(xbar); peers::gx_phase(xn, x8, sxq, rowpart, rstdv); { MAKE_P0ARGS(A); ph_p0(A, lds, 32, 0); } xcd_wait(xbar);
    { route::RArgs RA{qb, skb, idx, gw}; route::route_phase(RA, (LAS char*)lds); }
    xcd_arrive(xbar); { MAKE_P0ARGS(A); ph_p0(A, lds, 32, 1); } xcd_wait(xbar);
    { float* zpart = (float*)(ws + 288 * MiB); float* actb = (float*)(ws + 96 * MiB);
      peers::SArgs SA{out, xn, rowpart, idx, gw, ein8, eout8, sc_in, sc_out, ple_norm, xn, zpart, actb, r2part, x8, sxq, (unsigned short*)actb, (float*)(ws + 86 * MiB), rstdv, (float*)(ws + 86 * MiB + 512 * 1024), ws + 144 * MiB};
      peers::ga_phase(SA, (LAS char*)lds);
#define PLE_UNIT(which_) do { pg8::EpiBf16P E_{ple_b, DM, 0}; pg8::Gemm g_{pbf, wt_ple, TOK, DM, 256, 0}; pg8::StaticOrderOne S_; S_.base.init(TOK, DM, (int)gridDim.x, (int)blockIdx.x); S_.which = (which_); \
        pg8::gemm_phase<pg8::EpiBf16P, pg8::StaticOrderOne, true, true>(l3, g_, S_, E_); } while (0)
      xcd_arrive(xbar); PLE_UNIT(0); xcd_wait(xbar);
      peers::gr_phase(SA);
      GRID_BAR();
      peers::gb_phase(SA, (LAS char*)lds); }
    xcd_arrive(xbar);
    PLE_UNIT(1);
    xcd_wait(xbar);
    { pg8::EpiGate E{out, xn, ple_b, r2part}; pg8::Gemm g_{(const bf16*)(ws + 144 * MiB), wt_gate, TOK, DM, DM / 2, 0}; pg8::StaticOrder S_; S_.init(TOK, DM, (int)gridDim.x, (int)blockIdx.x);
      pg8::gemm_phase<pg8::EpiGate, pg8::StaticOrder, true, true, true>(l3, g_, S_, E); }
}

extern "C" void kernel_launch(void* const* d_in, const int* in_sizes, int n_in, void* d_out, int out_size, void* d_ws, size_t ws_size, hipStream_t stream) {
    static int grid = 0;
    if (grid == 0) {
        if (n_in != 24 || ws_size < WS_END) { fprintf(stderr, "kernel_launch: unexpected n_in %d / ws %zu\n", n_in, ws_size); grid = -1; return; }
        int dev = 0, cus = 0, per_cu = 0;
        (void)hipGetDevice(&dev); (void)hipDeviceGetAttribute(&cus, hipDeviceAttributeMultiprocessorCount, dev);
        if (hipFuncSetAttribute((const void*)mega, hipFuncAttributeMaxDynamicSharedMemorySize, LDS_BYTES) != hipSuccess) { fprintf(stderr, "kernel_launch: hipFuncSetAttribute failed\n"); grid = -1; return; }
        if (hipOccupancyMaxActiveBlocksPerMultiprocessor(&per_cu, (const void*)mega, 512, LDS_BYTES) != hipSuccess || per_cu < 1) { fprintf(stderr, "kernel_launch: occupancy query failed (%d)\n", per_cu); grid = -1; return; }
        grid = cus * per_cu;
        fprintf(stderr, "kernel_launch: cus %d per_cu %d grid %d\n", cus, per_cu, grid);
    }
    if (grid < 0) return;
    Params P{};
    for (int i = 0; i < 24; ++i) P.in[i] = (const float*)d_in[i];
    P.out = (float*)d_out; P.ws = (unsigned char*)d_ws;
    (void)hipMemsetAsync((unsigned char*)d_ws + WS_CTL, 0, (XCD_BAR_WORDS + 128) * sizeof(unsigned), stream);
    void* args[] = {&P};
    hipError_t e = hipLaunchCooperativeKernel((const void*)mega, dim3(grid), dim3(512), args, LDS_BYTES, stream);
    if (e != hipSuccess) fprintf(stderr, "kernel_launch: cooperative launch failed: %s (grid %d)\n", hipGetErrorString(e), grid);
}
```

```cpp
#include <hip/hip_runtime.h>
#include <hip/hip_cooperative_groups.h>
#include <cstdio>
#include <cstdint>
#include <cmath>
namespace pg8 {
#define PG8_LAS __attribute__((address_space(3)))
typedef unsigned short bf16_t;
typedef short bf16x8 __attribute__((ext_vector_type(8)));
typedef float f32x4 __attribute__((ext_vector_type(4)));
typedef float f32x2 __attribute__((ext_vector_type(2)));
typedef unsigned u32x4 __attribute__((ext_vector_type(4)));
constexpr int BM = 256, BK = 64, HALF = 128, HTB = HALF * BK * 2  , STAGE_BYTES = 8 * HTB, NXCD = 8, WGM = 8;

__host__ __device__ __forceinline__ int lds_byte(int r, int c) { const int st = (r >> 4) * 2 + (c >> 5), rr = r & 15, cc = c & 31, ob = rr * 64 + cc * 2; return st * 1024 + (ob ^ (((ob >> 9) & 1) << 5)); }
__host__ __device__ __forceinline__ void stage_rc(int b, int& R, int& C) { const int st = b / 1024, sb = b % 1024, swz = sb ^ (((sb >> 9) & 1) << 5); R = (st >> 1) * 16 + swz / 64; C = (st & 1) * 32 + (swz % 64) / 2; }
__host__ __device__ __forceinline__ int perm32(int rho) { const int n = rho >> 4, i = rho & 15; return 8 * (i >> 2) + 4 * n + (i & 3); }

struct Unit { int pm, pn; };
struct Gemm { const bf16_t* A; const bf16_t* Bt; int M, N, K, pad; };

struct StaticOrder {
    int nM, nN, nwg, G, c;
    __host__ __device__ void init(int M, int N, int G_, int c_) { nM = M / BM; nN = N / BM; nwg = nM * nN; G = G_; c = c_; }
    __host__ __device__ bool next(int i, Unit& u) const {
        const long L = (long)i * G + c; if (L >= nwg) return false;
        int wgid = (int)L; { const int q = nwg / NXCD, r = nwg % NXCD, xcd = wgid % NXCD, off = wgid / NXCD; wgid = (xcd < r ? xcd * (q + 1) : r * (q + 1) + (xcd - r) * q) + off; }
        const int nig = WGM * nN, gid = wgid / nig, fm = gid * WGM, gsz = (nM - fm) < WGM ? (nM - fm) : WGM;
        u.pm = fm + ((wgid % nig) % gsz); u.pn = (wgid % nig) / gsz; return true;
    }
    __device__ __forceinline__ void a_ready(const Unit&) const {}
    __device__ __forceinline__ void done(const Unit&) const {}
};

__device__ __forceinline__ unsigned cvt_pk_bf16(float lo, float hi) { unsigned r; asm volatile("v_cvt_pk_bf16_f32 %0, %1, %2" : "=v"(r) : "v"(lo), "v"(hi)); return r; }
typedef float f32x2 __attribute__((ext_vector_type(2)));
struct EpiBf16P {
    static constexpr bool PERM = true, AFTER_DRAIN = false;
    bf16_t* O; int ldc, pad;
    __device__ __forceinline__ void operator()(const f32x4 (&acc)[2][2][4][2], const Unit& u, int wr, int wc, int fr, int fq) const {
        int t_o = threadIdx.x; asm volatile("" : "+v"(t_o)); const int fr_o = t_o & 15, fq_o = (t_o >> 4) & 3;
        const int row0 = u.pm * BM + wr * 64 + fr_o; const int col0 = u.pn * BM + wc * 32 + 8 * fq_o;
#pragma unroll
        for (int ai = 0; ai < 2; ++ai)
#pragma unroll
            for (int m = 0; m < 4; ++m) { bf16_t* rowp = O + (size_t)(row0 + ai * HALF + m * 16) * ldc + col0;
#pragma unroll
                for (int bj = 0; bj < 2; ++bj) { const f32x4 v0 = acc[ai][bj][m][0], v1 = acc[ai][bj][m][1];
                    u32x4 w; w.x = cvt_pk_bf16(v0[0], v0[1]); w.y = cvt_pk_bf16(v0[2], v0[3]); w.z = cvt_pk_bf16(v1[0], v1[1]); w.w = cvt_pk_bf16(v1[2], v1[3]);
                    *(u32x4*)(rowp + bj * HALF) = w; } }
    }
};
struct EpiQKV {
    static constexpr bool PERM = true, AFTER_DRAIN = false;
    bf16_t* qkv; const float* gains;
    static constexpr size_t SEC = (size_t)8 * 8 * 4096 * 64;
    __device__ __forceinline__ void operator()(const f32x4 (&acc)[2][2][4][2], const Unit& u, int wr, int wc, int fr_, int fq_) const {
        int t_o = threadIdx.x; asm volatile("" : "+v"(t_o)); const int fr = t_o & 15, fq = (t_o >> 4) & 3;
        const int sec = u.pn >> 1, head = 4 * (u.pn & 1) + wc;
        bf16_t* dst = qkv + (size_t)sec * SEC;
        const bool isq = (sec == 0 || sec == 3), isk = (sec == 1 || sec == 4), fox = sec < 3;
        f32x4 g[2][2];
        if (isq || isk) { const float* gp = gains + (sec == 0 ? 0 : sec == 1 ? 64 : sec == 3 ? 128 : 160);
#pragma unroll
            for (int bj = 0; bj < 2; ++bj)
#pragma unroll
                for (int n = 0; n < 2; ++n) g[bj][n] = *(const f32x4*)(gp + (fox ? 32 * bj : 0) + 8 * fq + 4 * n); }
        const float qs = isq ? (fox ? 0.125f * 1.4426950408889634f : 0.17677669529663687f * 1.4426950408889634f) : 1.f;
#pragma unroll
        for (int ai = 0; ai < 2; ++ai)
#pragma unroll
            for (int m = 0; m < 4; ++m) {
                const int r = u.pm * BM + ai * HALF + wr * 64 + m * 16 + fr, b = r >> 12, s = r & 4095, bh = b * 8 + head;
                f32x4 v[2][2];
#pragma unroll
                for (int bj = 0; bj < 2; ++bj)
#pragma unroll
                    for (int n = 0; n < 2; ++n) v[bj][n] = acc[ai][bj][m][n];
                if (isq || isk) {
                    float ss[2];
#pragma unroll
                    for (int bj = 0; bj < 2; ++bj) { const f32x4 a = v[bj][0], c = v[bj][1]; ss[bj] = (a[0] * a[0] + a[1] * a[1]) + (a[2] * a[2] + a[3] * a[3]) + (c[0] * c[0] + c[1] * c[1]) + (c[2] * c[2] + c[3] * c[3]); }
                    if (fox) { ss[0] += ss[1]; ss[1] = ss[0]; }
#pragma unroll
                    for (int bj = 0; bj < 2; ++bj) { ss[bj] += __shfl_xor(ss[bj], 16); ss[bj] += __shfl_xor(ss[bj], 32); }
#pragma unroll
                    for (int bj = 0; bj < 2; ++bj) { const float rr = __builtin_amdgcn_rsqf(ss[bj] * (fox ? 1.f / 64 : 1.f / 32) + 1e-6f) * qs;
#pragma unroll
                        for (int n = 0; n < 2; ++n) v[bj][n] = v[bj][n] * rr * g[bj][n]; }
                }
#pragma unroll
                for (int bj = 0; bj < 2; ++bj) {
                    u32x4 w; w.x = cvt_pk_bf16(v[bj][0][0], v[bj][0][1]); w.y = cvt_pk_bf16(v[bj][0][2], v[bj][0][3]); w.z = cvt_pk_bf16(v[bj][1][0], v[bj][1][1]); w.w = cvt_pk_bf16(v[bj][1][2], v[bj][1][3]);
                    size_t off;
                    if (isq) off = ((size_t)bh * 4096 + s) * 64 + 32 * bj + 8 * fq;
                    else if (isk) off = ((size_t)bh * 64 + (s >> 6)) * 4096 + (4 * bj + fq) * 512 + (s & 63) * 8;
                    else off = ((size_t)bh * 64 + (s >> 6)) * 4096 + bj * 2048 + (s & 63) * 32 + 8 * fq;
                    *(u32x4*)(dst + off) = w;
                }
            }
    }
};
struct EpiResNorm {
    static constexpr bool PERM = true, AFTER_DRAIN = false;
    const float* base; bf16_t* xb; float* rowpart;
    __device__ __forceinline__ void operator()(const f32x4 (&acc)[2][2][4][2], const Unit& u, int wr, int wc, int fr, int fq) const {
        int t_o = threadIdx.x; asm volatile("" : "+v"(t_o)); const int fr_o = t_o & 15, fq_o = (t_o >> 4) & 3;
        const int row0 = u.pm * BM + wr * 64 + fr_o; const int col0 = u.pn * BM + wc * 32 + 8 * fq_o;
#pragma unroll
        for (int ai = 0; ai < 2; ++ai)
#pragma unroll
            for (int m = 0; m < 4; ++m) { const int row = row0 + ai * HALF + m * 16; const size_t off = (size_t)row * 1024 + col0; float ss = 0.f;
#pragma unroll
                for (int bj = 0; bj < 2; ++bj) { const f32x4 o0 = acc[ai][bj][m][0] * (1.f / 32.f) + *(const f32x4*)(base + off + bj * HALF), o1 = acc[ai][bj][m][1] * (1.f / 32.f) + *(const f32x4*)(base + off + bj * HALF + 4);
                    ss += ((o0[0] * o0[0] + o0[1] * o0[1]) + (o0[2] * o0[2] + o0[3] * o0[3])) + ((o1[0] * o1[0] + o1[1] * o1[1]) + (o1[2] * o1[2] + o1[3] * o1[3]));
                    u32x4 w; w.x = cvt_pk_bf16(o0[0], o0[1]); w.y = cvt_pk_bf16(o0[2], o0[3]); w.z = cvt_pk_bf16(o1[0], o1[1]); w.w = cvt_pk_bf16(o1[2], o1[3]);
                    *(u32x4*)(xb + off + bj * HALF) = w; }
                ss += __shfl_xor(ss, 16); ss += __shfl_xor(ss, 32);
                if (fq_o == 0) rowpart[(size_t)row * 16 + u.pn * 4 + wc] = ss; }
    }
};
__device__ __forceinline__ float row_rstd(const float* rowpart, int row) {
    const f32x4* p = (const f32x4*)(rowpart + (size_t)row * 16); const f32x4 a = p[0], b = p[1], c = p[2], d = p[3];
    const float s = (((a[0] + a[1]) + (a[2] + a[3])) + ((b[0] + b[1]) + (b[2] + b[3]))) + (((c[0] + c[1]) + (c[2] + c[3])) + ((d[0] + d[1]) + (d[2] + d[3])));
    return __builtin_amdgcn_rsqf(s * (1.f / 1024) + 1e-6f);
}
struct EpiBf16Row {
    static constexpr bool PERM = true, AFTER_DRAIN = false;
    bf16_t* O; const float* rowpart; int ldc, pad;
    __device__ __forceinline__ void operator()(const f32x4 (&acc)[2][2][4][2], const Unit& u, int wr, int wc, int fr, int fq) const {
        int t_o = threadIdx.x; asm volatile("" : "+v"(t_o)); const int fr_o = t_o & 15, fq_o = (t_o >> 4) & 3;
        const int row0 = u.pm * BM + wr * 64 + fr_o; const int col0 = u.pn * BM + wc * 32 + 8 * fq_o;
#pragma unroll
        for (int ai = 0; ai < 2; ++ai)
#pragma unroll
            for (int m = 0; m < 4; ++m) { const int row = row0 + ai * HALF + m * 16; bf16_t* rowp = O + (size_t)row * ldc + col0;
                float r; { const f32x4 pv = ((const f32x4*)(rowpart + (size_t)row * 16))[fq_o]; float sp = (pv[0] + pv[1]) + (pv[2] + pv[3]); sp += __shfl_xor(sp, 16); sp += __shfl_xor(sp, 32);
                  r = __builtin_amdgcn_rsqf(sp * (1.f / 1024) + 1e-6f); }
#pragma unroll
                for (int bj = 0; bj < 2; ++bj) { const f32x4 v0 = acc[ai][bj][m][0] * r, v1 = acc[ai][bj][m][1] * r;
                    u32x4 w; w.x = cvt_pk_bf16(v0[0], v0[1]); w.y = cvt_pk_bf16(v0[2], v0[3]); w.z = cvt_pk_bf16(v1[0], v1[1]); w.w = cvt_pk_bf16(v1[2], v1[3]);
                    *(u32x4*)(rowp + bj * HALF) = w; } }
    }
};
struct EpiGate {
    static constexpr bool PERM = true, AFTER_DRAIN = false;
    float* out; const bf16_t* hb; const bf16_t* ple; const float* r2part;
    __device__ __forceinline__ void operator()(const f32x4 (&acc)[2][2][4][2], const Unit& u, int wr, int wc, int fr, int fq) const {
        int t_o = threadIdx.x; asm volatile("" : "+v"(t_o)); const int fr_o = t_o & 15, fq_o = (t_o >> 4) & 3;
        const int row0 = u.pm * BM + wr * 64 + fr_o; const int col0 = u.pn * BM + wc * 32 + 8 * fq_o;
#pragma unroll
        for (int ai = 0; ai < 2; ++ai)
#pragma unroll
            for (int m = 0; m < 4; ++m) { const int row = row0 + ai * HALF + m * 16; const size_t off = (size_t)row * 1024 + col0;
                const f32x4 q0 = *(const f32x4*)(r2part + (size_t)row * 4);
                const float r2 = (-1.4426950408889634f / 32.f) * __builtin_amdgcn_rsqf(((q0[0] + q0[1]) + (q0[2] + q0[3])) * (1.f / 1024) + 1e-6f);
#pragma unroll
                for (int bj = 0; bj < 2; ++bj) { const size_t o2 = off + bj * HALF; const u32x4 hw = *(const u32x4*)(hb + o2), pw = *(const u32x4*)(ple + o2);
#pragma unroll
                    for (int n = 0; n < 2; ++n) { const f32x4 a = acc[ai][bj][m][n] * r2; const unsigned h01 = n ? hw.z : hw.x, h23 = n ? hw.w : hw.y, p01 = n ? pw.z : pw.x, p23 = n ? pw.w : pw.y; f32x4 o;
                        o[0] = __builtin_bit_cast(float, h01 << 16) + __builtin_bit_cast(float, p01 << 16) * __builtin_amdgcn_rcpf(1.f + __builtin_amdgcn_exp2f(a[0]));
                        o[1] = __builtin_bit_cast(float, h01 & 0xffff0000u) + __builtin_bit_cast(float, p01 & 0xffff0000u) * __builtin_amdgcn_rcpf(1.f + __builtin_amdgcn_exp2f(a[1]));
                        o[2] = __builtin_bit_cast(float, h23 << 16) + __builtin_bit_cast(float, p23 << 16) * __builtin_amdgcn_rcpf(1.f + __builtin_amdgcn_exp2f(a[2]));
                        o[3] = __builtin_bit_cast(float, h23 & 0xffff0000u) + __builtin_bit_cast(float, p23 & 0xffff0000u) * __builtin_amdgcn_rcpf(1.f + __builtin_amdgcn_exp2f(a[3]));
                        __builtin_nontemporal_store(o, (f32x4*)(out + o2 + 4 * n)); } } }
    }
};
template <class Epi, class Sched, bool ALIGN_EPI = false, bool SP2 = false, bool FP8 = false>
__device__ __forceinline__ void gemm_phase(PG8_LAS unsigned char* lds, const Gemm g, const Sched& S, const Epi& E) {
    int tid_o = threadIdx.x; asm volatile("" : "+v"(tid_o));
    const int tid = tid_o, wid = __builtin_amdgcn_readfirstlane(tid >> 6), lane = tid & 63, wr = wid >> 2, wc = wid & 3, fr = lane & 15, fq = lane >> 4;
    const int K = g.K, nt = K / BK;
    unsigned voffA[2], voffB[2];
#pragma unroll
    for (int i = 0; i < 2; ++i) { int R, C; stage_rc(tid * 16 + i * 8192, R, C); const int Rb = Epi::PERM ? ((R & ~31) + perm32(R & 31)) : R;
        voffA[i] = (unsigned)(R * K + C) * 2u; voffB[i] = (unsigned)(Rb * K + C) * 2u; }
    const size_t kstep = (size_t)(BK * 2);
    const size_t hstep = (size_t)HALF * K * 2;
    const size_t tstep = 2 * hstep;
    const unsigned ldsw = (unsigned)wid * 1024u;
    const int aoff = lds_byte(wr * 64 + fr, fq * 8), boff = lds_byte(wc * 32 + fr, fq * 8);
#define PG8_SA(b, h) (((b) * 2 + (h)) * HTB)
#define PG8_SB(b, h) ((4 + (b) * 2 + (h)) * HTB)
#define PG8_STAGE(bufoff, gbase, voff) do { _Pragma("unroll") for (int _i = 0; _i < 2; ++_i) \
        __builtin_amdgcn_global_load_lds((const unsigned*)((const char*)(gbase) + (voff)[_i]), (PG8_LAS unsigned*)(lds + (bufoff) + ldsw + _i * 8192), 16, 0, 0); } while (0)
    typedef int v4i_t __attribute__((ext_vector_type(4))); typedef int v8i_t __attribute__((ext_vector_type(8)));
#define PG8_LDA(dst, b, h) do { if constexpr (FP8) { _Pragma("unroll") for (int m = 0; m < 4; ++m) { const v4i_t lo_ = *(const PG8_LAS v4i_t*)(lds + PG8_SA(b, h) + aoff + m * 2048), hi_ = *(const PG8_LAS v4i_t*)(lds + PG8_SA(b, h) + aoff + m * 2048 + 1024); \
            dst##8[m] = __builtin_shufflevector(lo_, hi_, 0, 1, 2, 3, 4, 5, 6, 7); } } \
        else { _Pragma("unroll") for (int m = 0; m < 4; ++m) _Pragma("unroll") for (int k = 0; k < 2; ++k) dst[m][k] = *(const PG8_LAS bf16x8*)(lds + PG8_SA(b, h) + aoff + m * 2048 + k * 1024); } } while (0)
#define PG8_LDB(dst, b, h) do { if constexpr (FP8) { _Pragma("unroll") for (int n = 0; n < 2; ++n) { const v4i_t lo_ = *(const PG8_LAS v4i_t*)(lds + PG8_SB(b, h) + boff + n * 2048), hi_ = *(const PG8_LAS v4i_t*)(lds + PG8_SB(b, h) + boff + n * 2048 + 1024); \
            dst##8[n] = __builtin_shufflevector(lo_, hi_, 0, 1, 2, 3, 4, 5, 6, 7); } } \
        else { _Pragma("unroll") for (int n = 0; n < 2; ++n) _Pragma("unroll") for (int k = 0; k < 2; ++k) dst[n][k] = *(const PG8_LAS bf16x8*)(lds + PG8_SB(b, h) + boff + n * 2048 + k * 1024); } } while (0)
#define PG8_MMA(ai, bj, At, Bt) do { __builtin_amdgcn_s_setprio(1); if constexpr (FP8) { _Pragma("unroll") for (int m = 0; m < 4; ++m) _Pragma("unroll") for (int n = 0; n < 2; ++n) \
            asm volatile("v_mfma_f32_16x16x128_f8f6f4 %0, %1, %2, %0" : "+v"(acc[ai][bj][m][n]) : "v"(Bt##8[n]), "v"(At##8[m])); } \
        else { _Pragma("unroll") for (int m = 0; m < 4; ++m) _Pragma("unroll") for (int n = 0; n < 2; ++n) _Pragma("unroll") for (int k = 0; k < 2; ++k) \
            acc[ai][bj][m][n] = __builtin_amdgcn_mfma_f32_16x16x32_bf16(Bt[n][k], At[m][k], acc[ai][bj][m][n], 0, 0, 0); } __builtin_amdgcn_s_setprio(0); } while (0)
#define PG8_WAIT_V(n) asm volatile("s_waitcnt vmcnt(" #n ")" ::: "memory")
#define PG8_WAIT_L(n) asm volatile("s_waitcnt lgkmcnt(" #n ")" ::: "memory")
#define PG8_BAR __builtin_amdgcn_s_barrier()
#define PG8_SCHED __builtin_amdgcn_sched_barrier(0)
    Unit cur, nxt; int ui = 0;
    if (!S.next(0, cur)) return;
    f32x4 acc[2][2][4][2];
#pragma unroll
    for (int a = 0; a < 2; ++a)
#pragma unroll
        for (int b = 0; b < 2; ++b)
#pragma unroll
            for (int m = 0; m < 4; ++m)
#pragma unroll
                for (int n = 0; n < 2; ++n) acc[a][b][m][n] = (f32x4){0.f, 0.f, 0.f, 0.f};
    bf16x8 At[4][2], B0[2][2], B1[2][2]; v8i_t At8[4], B08[2], B18[2];
    const char* cA = (const char*)g.A + (size_t)cur.pm * tstep; const char* cB = (const char*)g.Bt + (size_t)cur.pn * tstep;
    S.a_ready(cur);
    if constexpr (SP2) {
        PG8_STAGE(PG8_SB(0, 0), cB, voffB); PG8_STAGE(PG8_SB(0, 1), cB + hstep, voffB); PG8_STAGE(PG8_SA(0, 0), cA, voffA); PG8_STAGE(PG8_SA(0, 1), cA + hstep, voffA);
        if (wr == 1) PG8_BAR;
        PG8_WAIT_V(2); PG8_BAR;
        PG8_STAGE(PG8_SB(1, 0), cB + kstep, voffB); PG8_STAGE(PG8_SA(1, 0), cA + kstep, voffA); PG8_STAGE(PG8_SB(1, 1), cB + hstep + kstep, voffB);
        PG8_WAIT_V(6); PG8_BAR;
    } else {
        PG8_STAGE(PG8_SB(0, 0), cB, voffB); PG8_STAGE(PG8_SA(0, 0), cA, voffA); PG8_STAGE(PG8_SB(0, 1), cB + hstep, voffB); PG8_STAGE(PG8_SA(0, 1), cA + hstep, voffA);
        if (wr == 1) PG8_BAR;
        PG8_WAIT_V(4); PG8_BAR;
        PG8_STAGE(PG8_SB(1, 0), cB + kstep, voffB); PG8_STAGE(PG8_SA(1, 0), cA + kstep, voffA); PG8_STAGE(PG8_SB(1, 1), cB + hstep + kstep, voffB);
        PG8_WAIT_V(6); PG8_BAR;
    }
    for (;;) {
        const bool has_next = S.next(ui + 1, nxt);
        const char* nA = has_next ? (const char*)g.A + (size_t)nxt.pm * tstep : cA; const char* nB = has_next ? (const char*)g.Bt + (size_t)nxt.pn * tstep : cB;
        for (int t = 0; t < nt; t += 2) {
            const bool last = (t == nt - 2);
            const char* a1 = cA + (size_t)(t + 1) * kstep;
            const char* a2 = last ? nA : cA + (size_t)(t + 2) * kstep; const char* b2 = last ? nB : cB + (size_t)(t + 2) * kstep;
            const char* a3 = a2 + kstep; const char* b3 = b2 + kstep;
            if (last && has_next) S.a_ready(nxt);
            if constexpr (SP2) {
            PG8_LDB(B0, 0, 0); PG8_LDB(B1, 0, 1); PG8_SCHED; PG8_LDA(At, 0, 0); PG8_STAGE(PG8_SA(1, 1), a1 + hstep, voffA);
            PG8_WAIT_V(8); PG8_WAIT_L(0); PG8_BAR; PG8_MMA(0, 0, At, B0); PG8_MMA(0, 1, At, B1); PG8_BAR; PG8_SCHED;
            PG8_LDA(At, 0, 1); PG8_STAGE(PG8_SB(0, 0), b2, voffB); PG8_STAGE(PG8_SB(0, 1), b2 + hstep, voffB); PG8_STAGE(PG8_SA(0, 0), a2, voffA);
            PG8_WAIT_V(8); PG8_WAIT_L(0); PG8_BAR; PG8_MMA(1, 0, At, B0); PG8_MMA(1, 1, At, B1); PG8_BAR; PG8_SCHED;
            PG8_LDB(B0, 1, 0); PG8_LDB(B1, 1, 1); PG8_SCHED; PG8_LDA(At, 1, 0); PG8_STAGE(PG8_SA(0, 1), a2 + hstep, voffA);
            PG8_WAIT_V(8); PG8_WAIT_L(0); PG8_BAR; PG8_MMA(0, 0, At, B0); PG8_MMA(0, 1, At, B1); PG8_BAR; PG8_SCHED;
            PG8_LDA(At, 1, 1); PG8_STAGE(PG8_SB(1, 0), b3, voffB); PG8_STAGE(PG8_SB(1, 1), b3 + hstep, voffB); PG8_STAGE(PG8_SA(1, 0), a3, voffA);
            PG8_WAIT_V(8); PG8_WAIT_L(0); PG8_BAR; PG8_MMA(1, 0, At, B0); PG8_MMA(1, 1, At, B1); PG8_BAR; PG8_SCHED;
            } else {
            PG8_LDB(B0, 0, 0); PG8_SCHED; PG8_LDA(At, 0, 0); PG8_STAGE(PG8_SA(1, 1), a1 + hstep, voffA);
            PG8_WAIT_L(8); PG8_BAR; PG8_WAIT_L(0); PG8_MMA(0, 0, At, B0); PG8_BAR; PG8_SCHED;
            PG8_LDB(B1, 0, 1); PG8_STAGE(PG8_SB(0, 0), b2, voffB);
            PG8_BAR; PG8_WAIT_L(0); PG8_MMA(0, 1, At, B1); PG8_BAR;
            PG8_LDA(At, 0, 1); PG8_STAGE(PG8_SA(0, 0), a2, voffA);
            PG8_BAR; PG8_WAIT_L(0); PG8_MMA(1, 0, At, B0); PG8_BAR; PG8_SCHED;
            PG8_STAGE(PG8_SB(0, 1), b2 + hstep, voffB);
            PG8_WAIT_V(6); PG8_BAR; PG8_MMA(1, 1, At, B1); PG8_BAR;
            PG8_LDB(B0, 1, 0); PG8_SCHED; PG8_LDA(At, 1, 0); PG8_STAGE(PG8_SA(0, 1), a2 + hstep, voffA);
            PG8_WAIT_L(8); PG8_BAR; PG8_WAIT_L(0); PG8_MMA(0, 0, At, B0); PG8_BAR; PG8_SCHED;
            PG8_LDB(B1, 1, 1); PG8_STAGE(PG8_SB(1, 0), b3, voffB);
            PG8_BAR; PG8_WAIT_L(0); PG8_MMA(0, 1, At, B1); PG8_BAR;
            PG8_LDA(At, 1, 1); PG8_STAGE(PG8_SA(1, 0), a3, voffA);
            PG8_BAR; PG8_WAIT_L(0); PG8_MMA(1, 0, At, B0); PG8_BAR; PG8_SCHED;
            PG8_STAGE(PG8_SB(1, 1), b3 + hstep, voffB);
            PG8_WAIT_V(6); PG8_BAR; PG8_MMA(1, 1, At, B1); PG8_BAR;
            }
        }
        if constexpr (ALIGN_EPI) { if (wr == 0) PG8_BAR; }
        if constexpr (FP8) asm volatile("s_nop 15\n\ts_nop 15" ::: "memory");
        if constexpr (!Epi::AFTER_DRAIN) { E(acc, cur, wr, wc, fr, fq); S.done(cur); }
        if (!has_next) break;
#pragma unroll
        for (int a = 0; a < 2; ++a)
#pragma unroll
            for (int b = 0; b < 2; ++b)
#pragma unroll
                for (int m = 0; m < 4; ++m)
#pragma unroll
                    for (int n = 0; n < 2; ++n) acc[a][b][m][n] = (f32x4){0.f, 0.f, 0.f, 0.f};
        cur = nxt; cA = nA; cB = nB; ++ui;
        if constexpr (ALIGN_EPI) { if (wr == 1) PG8_BAR; }
    }
    PG8_WAIT_V(0);
    if constexpr (!ALIGN_EPI) { if (wr == 0) PG8_BAR; }
    PG8_BAR;
    if constexpr (Epi::AFTER_DRAIN) { E.fused(acc, cur, wr, wc, fr, fq, lds, wid, lane); S.done(cur); }
#undef PG8_SA
#undef PG8_SB
#undef PG8_STAGE
#undef PG8_LDA
#undef PG8_LDB
#undef PG8_MMA
#undef PG8_WAIT_V
#undef PG8_WAIT_L
#undef PG8_BAR
#undef PG8_SCHED
}
}

constexpr int NB = 8, SEQ = 4096, DM = 1024, TOK = NB * SEQ, NPROJ = 3080, NPROJ_PAD = 3328;
constexpr int OFF_QF = 0, OFF_KF = 512, OFF_VF = 1024, OFF_FL = 1536, OFF_QD = 1544, OFF_KD = 2056, OFF_VD = 2568;
constexpr float EPS = 1e-6f;
constexpr size_t MiB = 1u << 20;
constexpr size_t WS_WT_IN = 0, WS_WT_OUT = 7 * MiB, WS_WT_Q = 9 * MiB, WS_WT_GATE = 13 * MiB, WS_WT_PLE = 15 * MiB, WS_XN = 16 * MiB,
                 WS_PROJ = 80 * MiB, WS_O = 80 * MiB, WS_GATE = 80 * MiB, WS_QKV = 288 * MiB, WS_Q = 288 * MiB, WS_PLE = 288 * MiB, WS_PBF = 416 * MiB,
                 WS_IDX = 480 * MiB, WS_G = 496 * MiB, WS_END = 512 * MiB;
constexpr size_t QKV_SEC = (size_t)NB * 8 * SEQ * 64;

typedef unsigned short bf16;
#define LAS __attribute__((address_space(3)))
__device__ __forceinline__ unsigned f2bf(float f) { unsigned u = __builtin_bit_cast(unsigned, f); return (u + 0x7fffu + ((u >> 16) & 1u)) >> 16; }
__device__ __forceinline__ float bf2f(unsigned short u) { return __builtin_bit_cast(float, (unsigned)u << 16); }
__device__ __forceinline__ float wave_sum(float v) {
    v += __builtin_bit_cast(float, __builtin_amdgcn_mov_dpp(__builtin_bit_cast(int, v), 0xB1, 0xf, 0xf, true));
    v += __builtin_bit_cast(float, __builtin_amdgcn_mov_dpp(__builtin_bit_cast(int, v), 0x4E, 0xf, 0xf, true));
    v += __builtin_bit_cast(float, __builtin_amdgcn_mov_dpp(__builtin_bit_cast(int, v), 0x141, 0xf, 0xf, true));
    v += __builtin_bit_cast(float, __builtin_amdgcn_mov_dpp(__builtin_bit_cast(int, v), 0x140, 0xf, 0xf, true));
    { auto r = __builtin_amdgcn_permlane16_swap(__float_as_uint(v), __float_as_uint(v), false, false); v = __uint_as_float(r[0]) + __uint_as_float(r[1]); }
    { auto r = __builtin_amdgcn_permlane32_swap(__float_as_uint(v), __float_as_uint(v), false, false); v = __uint_as_float(r[0]) + __uint_as_float(r[1]); }
    return v;
}
__device__ __forceinline__ float wave_max(float v) {
    v = fmaxf(v, __builtin_bit_cast(float, __builtin_amdgcn_mov_dpp(__builtin_bit_cast(int, v), 0xB1, 0xf, 0xf, true)));
    v = fmaxf(v, __builtin_bit_cast(float, __builtin_amdgcn_mov_dpp(__builtin_bit_cast(int, v), 0x4E, 0xf, 0xf, true)));
    v = fmaxf(v, __builtin_bit_cast(float, __builtin_amdgcn_mov_dpp(__builtin_bit_cast(int, v), 0x141, 0xf, 0xf, true)));
    v = fmaxf(v, __builtin_bit_cast(float, __builtin_amdgcn_mov_dpp(__builtin_bit_cast(int, v), 0x140, 0xf, 0xf, true)));
    { auto r = __builtin_amdgcn_permlane16_swap(__float_as_uint(v), __float_as_uint(v), false, false); v = fmaxf(__uint_as_float(r[0]), __uint_as_float(r[1])); }
    { auto r = __builtin_amdgcn_permlane32_swap(__float_as_uint(v), __float_as_uint(v), false, false); v = fmaxf(__uint_as_float(r[0]), __uint_as_float(r[1])); }
    return v;
}
__device__ __forceinline__ int tid_opaque() { int t = threadIdx.x; asm volatile("" : "+v"(t)); return t; }
__device__ __forceinline__ float log_sigmoid(float z) { return fminf(z, 0.f) - log1pf(expf(-fabsf(z))); }

typedef unsigned v4u __attribute__((ext_vector_type(4)));
typedef float f32x4 __attribute__((ext_vector_type(4)));
#define LDS_WAIT() asm volatile("s_waitcnt lgkmcnt(0)" ::: "memory")
__device__ __forceinline__ unsigned pk2(float lo, float hi) { return f2bf(lo) | (f2bf(hi) << 16); }
__device__ __forceinline__ void tr_item(const float* W, int ldw, int K, int src_col0, bf16* WT, int dst_row0, int kb, LAS float* scr, int lane, const float* gk = nullptr) {
    const int k0 = 64 * kb;
#pragma unroll 8
    for (int i = 0; i < 32; ++i) { const int kk = 2 * i + (lane >> 5); float w = W[(size_t)(k0 + kk) * ldw + src_col0 + (lane & 31)]; if (gk) w *= gk[k0 + kk]; scr[kk * 33 + (lane & 31)] = w; }
    LDS_WAIT(); asm volatile("" ::: "memory");
    const int c = lane & 7;
#pragma unroll
    for (int j = 0; j < 4; ++j) { const int n = (lane >> 3) + 8 * j; const LAS float* s = scr + (8 * c) * 33 + n;
        v4u o; o.x = pk2(s[0 * 33], s[1 * 33]); o.y = pk2(s[2 * 33], s[3 * 33]); o.z = pk2(s[4 * 33], s[5 * 33]); o.w = pk2(s[6 * 33], s[7 * 33]);
        *(v4u*)(WT + (size_t)(dst_row0 + n) * K + k0 + 8 * c) = o; }
    LDS_WAIT(); asm volatile("" ::: "memory");
}
__device__ __forceinline__ void tr_item8(const float* W, int ldw, int K, int src_col0, unsigned char* WT8, int dst_row0, int kb, LAS float* scr, int lane, float scale, const float* gk) {
    const int k0 = 64 * kb;
    { float wv[32];
#pragma unroll
      for (int i = 0; i < 32; ++i) { const int kk = 2 * i + (lane >> 5); wv[i] = W[(size_t)(k0 + kk) * ldw + src_col0 + (lane & 31)]; }
#pragma unroll
      for (int i = 0; i < 32; ++i) scr[(2 * i + (lane >> 5)) * 33 + (lane & 31)] = wv[i] * (gk ? scale * gk[k0 + 2 * i + (lane >> 5)] : scale); }
    LDS_WAIT(); asm volatile("" ::: "memory");
    const int c = lane & 7;
#pragma unroll
    for (int j = 0; j < 4; ++j) { const int n = (lane >> 3) + 8 * j; const LAS float* s = scr + (8 * c) * 33 + n;
        int lo = 0, hi = 0; lo = __builtin_amdgcn_cvt_pk_fp8_f32(s[0 * 33], s[1 * 33], lo, false); lo = __builtin_amdgcn_cvt_pk_fp8_f32(s[2 * 33], s[3 * 33], lo, true);
        hi = __builtin_amdgcn_cvt_pk_fp8_f32(s[4 * 33], s[5 * 33], hi, false); hi = __builtin_amdgcn_cvt_pk_fp8_f32(s[6 * 33], s[7 * 33], hi, true);
        typedef unsigned u32x2_t __attribute__((ext_vector_type(2))); u32x2_t o; o.x = (unsigned)lo; o.y = (unsigned)hi;
        *(u32x2_t*)(WT8 + (size_t)(dst_row0 + n) * K + k0 + 8 * c) = o; }
    LDS_WAIT(); asm volatile("" ::: "memory");
}
__device__ __forceinline__ int win_src_col(int g) {
    const int tile = g >> 3, bj = (g >> 2) & 1, wc = g & 3, sec = tile >> 1, head = 4 * (tile & 1) + wc;
    const int base = sec == 0 ? OFF_QF : sec == 1 ? OFF_KF : sec == 2 ? OFF_VF : sec == 3 ? OFF_QD : sec == 4 ? OFF_KD : OFF_VD;
    return base + head * 64 + 32 * bj;
}
__device__ __forceinline__ void cvt8(const float* __restrict__ in, bf16* __restrict__ out, size_t n8, size_t gt, size_t ngt) {
    for (size_t i = gt; i < n8; i += ngt) { const f32x4 a = ((const f32x4*)in)[2 * i], b = ((const f32x4*)in)[2 * i + 1];
        v4u o; o.x = pk2(a[0], a[1]); o.y = pk2(a[2], a[3]); o.z = pk2(b[0], b[1]); o.w = pk2(b[2], b[3]); ((v4u*)out)[i] = o; }
}
__device__ __forceinline__ float reduce8(const float (&a8)[8], int lane) {
    const bool b0 = lane & 1, b1 = lane & 2, b2 = lane & 4; float c4[4], c2[2];
#pragma unroll
    for (int i = 0; i < 4; ++i) { const float keep = b0 ? a8[4 + i] : a8[i], send = b0 ? a8[i] : a8[4 + i]; c4[i] = keep + __builtin_bit_cast(float, __builtin_amdgcn_mov_dpp(__builtin_bit_cast(int, send), 0xB1, 0xf, 0xf, true)); }
#pragma unroll
    for (int i = 0; i < 2; ++i) { const float keep = b1 ? c4[2 + i] : c4[i], send = b1 ? c4[i] : c4[2 + i]; c2[i] = keep + __builtin_bit_cast(float, __builtin_amdgcn_mov_dpp(__builtin_bit_cast(int, send), 0x4E, 0xf, 0xf, true)); }
    float fl; { const float keep = b2 ? c2[1] : c2[0], send = b2 ? c2[0] : c2[1];
        const float up = __builtin_bit_cast(float, __builtin_amdgcn_mov_dpp(__builtin_bit_cast(int, send), 0x104, 0xf, 0xf, true)), dn = __builtin_bit_cast(float, __builtin_amdgcn_mov_dpp(__builtin_bit_cast(int, send), 0x114, 0xf, 0xf, true));
        fl = keep + (b2 ? dn : up); }
    fl += __builtin_bit_cast(float, __builtin_amdgcn_mov_dpp(__builtin_bit_cast(int, fl), 0x128, 0xf, 0xf, true));
    { auto r_ = __builtin_amdgcn_permlane16_swap(__float_as_uint(fl), __float_as_uint(fl), false, false); fl = __uint_as_float(r_[0]) + __uint_as_float(r_[1]); }
    { auto r_ = __builtin_amdgcn_permlane32_swap(__float_as_uint(fl), __float_as_uint(fl), false, false); fl = __uint_as_float(r_[0]) + __uint_as_float(r_[1]); }
    return fl;
}
struct P0Args { const float *x, *p, *mix_norm, *w_in, *b_f, *w_out, *w_query, *sub_keys, *e_in, *e_out, *w_gate, *w_ple;
                bf16 *wt_in, *wt_out, *wt_q, *wt_gate, *wt_ple, *skb; unsigned char *ein8, *eout8; float *sin, *sout; bf16 *pbf, *xn; float *cloc, *ttot; const float *gfq, *gfk, *gdq, *gdk; float* gains; const float *lq1, *lk1, *lq2, *lk2, *table; float* consts; const float *peer_norm, *ple_norm; };
__device__ __forceinline__ void ph_p0(const P0Args& A, unsigned char* lds, const int sect) {
    const int tid = tid_opaque(), lane = tid & 63, wave = tid >> 6;
    const int gw = blockIdx.x * 8 + wave, ngw = gridDim.x * 8;
    if ((sect & 8) && blockIdx.x == 0 && tid < 192) A.gains[tid] = tid < 64 ? A.gfq[tid] : tid < 128 ? A.gfk[tid - 64] : tid < 160 ? A.gdq[tid - 128] : A.gdk[tid - 160];
    if ((sect & 8) && blockIdx.x == 0 && wave == 0) {
        const float mqf = wave_max(fabsf(A.gfq[lane])), mkf = wave_max(fabsf(A.gfk[lane]));
        const int l32 = lane & 31; const bool lo = lane < 32;
        const float mqd = wave_max(fabsf(A.gdq[l32])), mkd = wave_max(fabsf(A.gdk[l32]));
        float mb[8];
#pragma unroll
        for (int h = 0; h < 8; ++h) mb[h] = wave_max(A.table[l32 * 8 + h]);
        const float s1 = wave_sum(lo ? A.lq1[l32] * A.lk1[l32] : 0.f), s2 = wave_sum(lo ? A.lq2[l32] * A.lk2[l32] : 0.f);
        if (lane == 0) { A.consts[0] = 8.f * mqf * mkf * 1.4426950408889634f;
#pragma unroll
            for (int h = 0; h < 8; ++h) A.consts[1 + h] = (5.656854249492381f * mqd * mkd + mb[h]) * 1.4426950408889634f;
            A.consts[9] = expf(s1) - expf(s2) + 0.2f; } }
    if (sect & 1) { LAS float* scr = (LAS float*)(lds) + wave * (64 * 33);
      for (int it = gw; it < 96 * 16; it += ngw) { const int g = it % 96, kb = it / 96; tr_item(A.w_in, NPROJ, DM, win_src_col(g), A.wt_in, 32 * g, kb, scr, lane); } }
    if (sect & 16) { LAS float* scr = (LAS float*)(lds) + wave * (64 * 33);
      constexpr int I_OUT = 32 * 16, I_Q = 64 * 16, I_G = 32 * 16, I_P = 32 * 4, NIT = I_OUT + I_Q + I_G + I_P;
      for (int it = gw; it < NIT; it += ngw) { int r = it;
          if (r < I_OUT) { const int g = r % 32, kb = r / 32; tr_item8(A.w_out, DM, DM, 32 * g, (unsigned char*)A.wt_out, 32 * g, kb, scr, lane, 32.f, nullptr); continue; }
          r -= I_OUT;
          if (r < I_Q) { const int g = r % 64, kb = r / 64; tr_item(A.w_query, 2048, DM, 32 * g, A.wt_q, 32 * g, kb, scr, lane, A.peer_norm); continue; }
          r -= I_Q;
          if (r < I_G) { const int g = r % 32, kb = r / 32; tr_item8(A.w_gate, DM, DM, 32 * g, (unsigned char*)A.wt_gate, 32 * g, kb, scr, lane, 32.f, A.ple_norm); continue; }
          r -= I_G;
          { const int g = r % 32, kb = r / 32; tr_item(A.w_ple, DM, 256, 32 * g, A.wt_ple, 32 * g, kb, scr, lane); } } }
    { const size_t gt = (size_t)blockIdx.x * 512 + tid, ngt = (size_t)gridDim.x * 512;
      if (sect & 2) cvt8(A.sub_keys, A.skb, (size_t)8 * 2 * 128 * 128 / 8, gt, ngt);
      if (sect & 64) cvt8(A.p, A.pbf, (size_t)TOK * 256 / 8, gt, ngt);
    }
#pragma unroll 1
    for (int tb = (sect & 4) ? 0 : 1; tb < ((sect & 32) ? 2 : 1); ++tb) { const bool second = tb == 1; const float* tsrc = second ? A.e_out : A.e_in; unsigned char* tdst = second ? A.eout8 : A.ein8; float* sdst = second ? A.sout : A.sin;
        f32x4 pn[4];
#pragma unroll
        for (int j = 0; j < 4; ++j) { pn[j] = ((const f32x4*)A.peer_norm)[lane * 4 + j]; if (second) pn[j] = (f32x4){1.f, 1.f, 1.f, 1.f}; }
#pragma unroll 1
        for (int e0 = gw; e0 < 16384; e0 += 4 * ngw) { f32x4 v[4][4];
#pragma unroll
            for (int q = 0; q < 4; ++q) { const int e = e0 + q * ngw; if (e < 16384) { const f32x4* src = (const f32x4*)(tsrc + (size_t)e * DM) + lane * 4;
#pragma unroll
                for (int j = 0; j < 4; ++j) v[q][j] = src[j]; } }
#pragma unroll
            for (int q = 0; q < 4; ++q) { const int e = e0 + q * ngw; if (e < 16384) { float mx = 0.f;
#pragma unroll
                for (int j = 0; j < 4; ++j) { v[q][j] = v[q][j] * pn[j]; mx = fmaxf(fmaxf(mx, fmaxf(fabsf(v[q][j][0]), fabsf(v[q][j][1]))), fmaxf(fabsf(v[q][j][2]), fabsf(v[q][j][3]))); }
                mx = wave_max(mx);
                {
                    float ssq = 0.f;
#pragma unroll
                    for (int j = 0; j < 4; ++j) ssq += (v[q][j][0] * v[q][j][0] + v[q][j][1] * v[q][j][1]) + (v[q][j][2] * v[q][j][2] + v[q][j][3] * v[q][j][3]);
                    ssq = wave_sum(ssq);
                    const float s1 = mx > 0.f ? 0.35f * sqrtf(ssq * (1.f / 1024.f)) : 1.f, s2 = mx > 0.f ? mx * (1.f / 7.f) : 1.f;
                    float clip = 0.f; const float lim = 7.f * s1;
#pragma unroll
                    for (int j = 0; j < 4; ++j)
#pragma unroll
                        for (int c = 0; c < 4; ++c) { const float ex = fmaxf(fabsf(v[q][j][c]) - lim, 0.f); clip = __builtin_fmaf(ex, ex, clip); }
                    clip = wave_sum(clip);
                    const float e1 = (1024.f / 12.f) * s1 * s1 + clip, e2 = (1024.f / 12.f) * s2 * s2;
                    const float sc = e1 <= e2 ? s1 : s2, inv = 1.f / sc; unsigned dw[2] = {0u, 0u};
#pragma unroll
                    for (int j = 0; j < 4; ++j)
#pragma unroll
                        for (int c = 0; c < 4; ++c) { int qi = (int)fminf(fmaxf(rintf(v[q][j][c] * inv), -7.f), 7.f); if (second && !(c & 1)) qi += 8;
                            dw[j >> 1] |= (unsigned)(qi & 15) << (4 * (4 * (j & 1) + c)); }
                    typedef unsigned u32x2_t __attribute__((ext_vector_type(2))); u32x2_t o; o.x = dw[0]; o.y = dw[1];
                    *(u32x2_t*)(tdst + (((size_t)(lane >> 4) * 16384 + e) << 7) + (lane & 15) * 8) = o;
                    if (lane == 0) sdst[e] = sc;
                } } } } }
    __syncthreads();
    if (!(sect & 8)) return;
    { float* wf = (float*)lds;
      float* lf = (float*)(lds + 32768);
      { f32x4 wa[2][2];
#pragma unroll
        for (int u = 0; u < 2; ++u) { const f32x4* p = (const f32x4*)(A.w_in + (size_t)(tid + 512 * u) * NPROJ + OFF_FL); wa[u][0] = p[0]; wa[u][1] = p[1]; }
#pragma unroll
        for (int u = 0; u < 2; ++u)
#pragma unroll
            for (int h = 0; h < 8; ++h) wf[h * DM + tid + 512 * u] = wa[u][h >> 2][h & 3]; }
      __syncthreads();
      f32x4 gg[4];
#pragma unroll
      for (int j = 0; j < 4; ++j) gg[j] = ((const f32x4*)A.mix_norm)[lane + 64 * j];
      for (int chunk = blockIdx.x; chunk < TOK / 128; chunk += gridDim.x) {
          f32x4 vb[2][2][4];
#define P0_LOADPAIR(buf, pp_) do { _Pragma("unroll") for (int u_ = 0; u_ < 2; ++u_) { const f32x4* xr_ = (const f32x4*)(A.x + ((size_t)chunk * 128 + wave * 16 + 2 * (pp_) + u_) * DM) + lane; \
              _Pragma("unroll") for (int j = 0; j < 4; ++j) vb[buf][u_][j] = xr_[64 * j]; } } while (0)
          P0_LOADPAIR(0, 0);
#pragma unroll 1
          for (int pg = 0; pg < 4; ++pg) {
#pragma unroll
            for (int q = 0; q < 2; ++q) { const int pp = 2 * pg + q; const int rl0 = wave * 16 + 2 * pp; const size_t row0 = (size_t)chunk * 128 + rl0;
              if (pp + 1 < 8) P0_LOADPAIR(q ^ 1, pp + 1);
              f32x4 v[2][4]; float ss[2] = {0.f, 0.f}, r[2];
#pragma unroll
              for (int u = 0; u < 2; ++u)
#pragma unroll
                  for (int j = 0; j < 4; ++j) { v[u][j] = vb[q][u][j];
#pragma unroll
                      for (int e = 0; e < 4; ++e) ss[u] = __builtin_fmaf(v[u][j][e], v[u][j][e], ss[u]); }
              ss[0] = wave_sum(ss[0]); ss[1] = wave_sum(ss[1]);
#pragma unroll
              for (int u = 0; u < 2; ++u) r[u] = rsqrtf(ss[u] * (1.f / DM) + EPS);
#pragma unroll
              for (int u = 0; u < 2; ++u)
#pragma unroll
                  for (int j = 0; j < 4; ++j) { v[u][j] = v[u][j] * r[u] * gg[j]; const unsigned long long o = (unsigned long long)pg8::cvt_pk_bf16(v[u][j][0], v[u][j][1]) | ((unsigned long long)pg8::cvt_pk_bf16(v[u][j][2], v[u][j][3]) << 32);
                      ((unsigned long long*)(A.xn + (row0 + u) * DM))[lane + 64 * j] = o; }
              float a8[2][8];
#pragma unroll
              for (int h = 0; h < 8; ++h) { float a0 = 0.f, a1 = 0.f;
#pragma unroll
                  for (int j = 0; j < 4; ++j) { const f32x4 w = ((const f32x4*)(wf + h * DM))[lane + 64 * j];
#pragma unroll
                      for (int e = 0; e < 4; ++e) { a0 = __builtin_fmaf(v[0][j][e], w[e], a0); a1 = __builtin_fmaf(v[1][j][e], w[e], a1); } }
                  a8[0][h] = a0; a8[1][h] = a1; }
              const float fl0 = reduce8(a8[0], lane), fl1 = reduce8(a8[1], lane);
              const int hsel = 4 * (lane & 1) + (lane & 2) + ((lane >> 2) & 1);
              if (lane < 8) { const float bf = A.b_f[hsel]; lf[rl0 * 8 + hsel] = fl0 + bf; lf[(rl0 + 1) * 8 + hsel] = fl1 + bf; }
            } }
#undef P0_LOADPAIR
          __syncthreads();
          { const int h = wave; const float v0 = log_sigmoid(lf[(2 * lane) * 8 + h]), v1 = log_sigmoid(lf[(2 * lane + 1) * 8 + h]); float incl = v0 + v1;
#pragma unroll
            for (int d = 1; d < 64; d <<= 1) { const float t = __shfl_up(incl, d); if (lane >= d) incl += t; }
            A.cloc[((size_t)chunk * 128 + 2 * lane) * 8 + h] = incl - v1; A.cloc[((size_t)chunk * 128 + 2 * lane + 1) * 8 + h] = incl;
            if (lane == 63) A.ttot[chunk * 8 + h] = incl; }
          __syncthreads();
      } }
}

namespace att {
typedef short bf16x8 __attribute__((ext_vector_type(8)));
typedef short s16x4 __attribute__((ext_vector_type(4)));
typedef short v4i16_t __attribute__((ext_vector_type(4)));
typedef float f32x16 __attribute__((ext_vector_type(16)));
typedef float f32x4 __attribute__((ext_vector_type(4)));
typedef float f32x2 __attribute__((ext_vector_type(2)));
typedef unsigned u32x4 __attribute__((ext_vector_type(4)));
typedef unsigned u32x2 __attribute__((ext_vector_type(2)));
typedef LAS const char* lptr;
constexpr int SLOTB = 16384, NSLOT = 3, L_CS = NSLOT * SLOTB, L_LUT = L_CS + 16384, L_SB = L_LUT + 1024, L_OST = L_SB + 512, OST_ROW = 144, L_END = L_OST + 8 * 32 * OST_ROW;
constexpr float LOG2E = 1.4426950408889634f;
__device__ __forceinline__ void glds16(const void* gsrc, unsigned lds_dst) { unsigned keep;
    asm volatile("s_mov_b32 %0, m0\n\ts_mov_b32 m0, %2\n\ts_nop 0\n\tglobal_load_lds_dwordx4 %1, off\n\ts_mov_b32 m0, %0" : "=&s"(keep) : "v"(gsrc), "s"(lds_dst) : "memory"); }
__device__ __forceinline__ s16x4 vtr(lptr p) { return __builtin_bit_cast(s16x4, __builtin_amdgcn_ds_read_tr16_b64_v4i16((LAS v4i16_t*)p)); }
__device__ __forceinline__ unsigned cvtpk(float lo, float hi) { typedef float f2 __attribute__((ext_vector_type(2))); typedef __bf16 b2 __attribute__((ext_vector_type(2))); f2 v = {lo, hi}; b2 b = __builtin_convertvector(v, b2); return __builtin_bit_cast(unsigned, b); }
__device__ __forceinline__ int crow(int r, int hi) { return (r & 3) + 8 * (r >> 2) + 4 * hi; }
__device__ __forceinline__ int t5_bucket_dev(int rel) {
    const int ret = rel > 0 ? 16 : 0; const int n = rel < 0 ? -rel : rel; const float nf = (float)(n < 1 ? 1 : n);
    int large = 8 + (int)(logf(nf / 8.f) / 2.772588722239781f * 8.f); large = large < 15 ? large : 15;
    return ret + (n < 8 ? n : large);
}
#define ATT_WAIT_BAR(N) asm volatile("s_waitcnt vmcnt(" #N ") lgkmcnt(0)\n\ts_barrier" ::: "memory")
struct Tensors { const bf16* img; bf16* O; const float* csg; unsigned* qctr; const float* consts; const float* table; const float* gsub; };

template <bool FOX> __device__ __forceinline__ void attn_unit(int bh, int qb, const Tensors& T, LAS char* shm, volatile LAS int* uslot, int nxt) {
    const int tid = tid_opaque(), lane = tid & 63, r32 = lane & 31, hi = lane >> 5; const int wid = __builtin_amdgcn_readfirstlane(tid >> 6);
    const int b = bh >> 3, h = bh & 7, q0 = qb * 256, qw = q0 + wid * 32;
    const bf16* Qs = T.img + (size_t)(FOX ? 0 : 3) * QKV_SEC + ((size_t)bh * SEQ + qw) * 64;
    const char* Kg = (const char*)(T.img + (size_t)(FOX ? 1 : 4) * QKV_SEC + (size_t)bh * 64 * 4096) + wid * 1024 + lane * 16;
    const char* Vg = (const char*)(T.img + (size_t)(FOX ? 2 : 5) * QKV_SEC + (size_t)bh * 64 * 4096) + wid * 1024 + lane * 16;
    const unsigned lds0 = (unsigned)(uintptr_t)shm;
    LAS float* cs = (LAS float*)(shm + L_CS); LAS float* lut = (LAS float*)(shm + L_LUT); LAS float* sb = (LAS float*)(shm + L_SB);
    const int NT = 4 * qb + 4, tl = 4 * qb + (wid >> 1);
    const float Mt = T.consts[FOX ? 0 : 1 + h];
    int t_start = 0, ts_w = 0; float thr2 = 0.f;
#define ATT_DMA(t, slot) do { glds16(Kg + (size_t)(t) * 8192, (unsigned)__builtin_amdgcn_readfirstlane(lds0 + (slot) * SLOTB + wid * 1024)); \
                              glds16(Vg + (size_t)(t) * 8192, (unsigned)__builtin_amdgcn_readfirstlane(lds0 + (slot) * SLOTB + 8192 + wid * 1024)); } while (0)
    bf16x8 qr[4]; float tfar = 0.f;
    if (FOX) {
        const float* csr = T.csg + (size_t)bh * SEQ; thr2 = 2.f * Mt + 42.f;
        const int n4 = (q0 + 256) >> 2;
        const int i0 = tid < n4 ? tid : n4 - 1, i1 = tid + 512 < n4 ? tid + 512 : n4 - 1;
        f32x4 c0 = *(const f32x4*)(csr + 4 * i0), c1 = *(const f32x4*)(csr + 4 * i1);
        const float csq0 = csr[q0]; const int c_l = lane < 2 * qb ? lane : 0; const float cend = csr[128 * c_l + 127];
#pragma unroll
        for (int d0 = 0; d0 < 4; ++d0) qr[d0] = *(const bf16x8*)(Qs + (size_t)r32 * 64 + d0 * 16 + hi * 8);
        asm volatile("" : "+v"(c0), "+v"(c1));
        if (tid < n4) *(LAS f32x4*)(cs + 4 * tid) = c0;
        if (tid + 512 < n4) *(LAS f32x4*)(cs + 4 * (tid + 512)) = c1;
        const int cst = __builtin_popcountll(__ballot(lane < 2 * qb && (csq0 - cend >= thr2)));
        t_start = __builtin_amdgcn_readfirstlane(2 * cst);
        asm volatile("" : "+v"(qr[0]), "+v"(qr[1]), "+v"(qr[2]), "+v"(qr[3]));
        ATT_DMA(t_start, 0);
    } else {
        ATT_DMA(0, 0);
        tfar = T.table[15 * 8 + h];
        const float tb = tid < 256 ? T.table[t5_bucket_dev(tid - 192) * 8 + h] : 0.f;
#pragma unroll
        for (int d0 = 0; d0 < 4; ++d0) qr[d0] = *(const bf16x8*)(Qs + (size_t)r32 * 64 + d0 * 16 + hi * 8);
        if (tid < 256) lut[tid] = (tb - tfar) * LOG2E;
        asm volatile("" : "+v"(qr[0]), "+v"(qr[1]), "+v"(qr[2]), "+v"(qr[3]));
    }
    asm volatile("s_waitcnt lgkmcnt(0)\n\ts_barrier" ::: "memory");
    float cq = 0.f;
    if (FOX) { cq = -cs[qw + r32] - Mt;
        const int ti = t_start + lane; const int ti_c = ti < tl ? ti : tl;
        ts_w = __builtin_amdgcn_readfirstlane(t_start + __builtin_popcountll(__ballot(ti < tl && (cs[qw] - cs[64 * ti_c + 63] >= thr2)))); }
    const float cfar = FOX ? 0.f : (tfar * LOG2E - Mt);
    f32x16 cfv;
#pragma unroll
    for (int r = 0; r < 16; ++r) cfv[r] = cfar;
    if (!FOX) asm volatile("" : "+v"(cfv));
    f32x16 o1[2], o2[2]; o1[0] = f32x16{}; o1[1] = f32x16{}; o2[0] = f32x16{}; o2[1] = f32x16{};
    float l1 = 0.f, l2 = 0.f;
    const lptr shm3 = (lptr)shm;
    const int koff = hi * 1024 + r32 * 16, voff = 8192 + ((lane >> 4) & 1) * 32 + (lane & 3) * 8 + (4 * hi + ((lane & 15) >> 2)) * 64;
    int slot = 0;
    for (int t = t_start; t < NT; ++t) {
        const int nslot = (slot == NSLOT - 1) ? 0 : slot + 1;
        if (t + 1 < NT) { ATT_DMA(t + 1, nslot); ATT_WAIT_BAR(2); } else { ATT_WAIT_BAR(0); }
        if (t >= ts_w && t <= tl) {
            const lptr kp = shm3 + slot * SLOTB + koff; const lptr vp = shm3 + slot * SLOTB + voff;
            const int k0 = 64 * t;
            u32x4 pw1[4], pw2[4];
            if (FOX) {
                f32x16 p0, p1; f32x16 cqv;
#pragma unroll
                for (int r = 0; r < 16; ++r) cqv[r] = cq;
#pragma unroll
                for (int d0 = 0; d0 < 4; ++d0) { const bf16x8 k0f = *(const LAS bf16x8*)(kp + d0 * 2048), k1f = *(const LAS bf16x8*)(kp + d0 * 2048 + 512);
                    p0 = __builtin_amdgcn_mfma_f32_32x32x16_bf16(k0f, qr[d0], d0 == 0 ? cqv : p0, 0, 0, 0); p1 = __builtin_amdgcn_mfma_f32_32x32x16_bf16(k1f, qr[d0], d0 == 0 ? cqv : p1, 0, 0, 0); }
#pragma unroll
                for (int g = 0; g < 4; ++g) { const f32x4 n0 = *(const LAS f32x4*)(cs + k0 + 8 * g + 4 * hi), n1 = *(const LAS f32x4*)(cs + k0 + 32 + 8 * g + 4 * hi);
#pragma unroll
                    for (int e = 0; e < 4; e += 2) { const f32x2 a0 = (f32x2){p0[4 * g + e], p0[4 * g + e + 1]} + (f32x2){n0[e], n0[e + 1]}, a1 = (f32x2){p1[4 * g + e], p1[4 * g + e + 1]} + (f32x2){n1[e], n1[e + 1]};
                        p0[4 * g + e] = __builtin_amdgcn_exp2f(a0[0]); p0[4 * g + e + 1] = __builtin_amdgcn_exp2f(a0[1]); p1[4 * g + e] = __builtin_amdgcn_exp2f(a1[0]); p1[4 * g + e + 1] = __builtin_amdgcn_exp2f(a1[1]); } }
                if (t == tl) { const int qrel = qw + r32 - k0 - 4 * hi;
#pragma unroll
                    for (int r = 0; r < 16; ++r) { const int kr = (r & 3) + 8 * (r >> 2); if (kr > qrel) p0[r] = 0.f; if (kr + 32 > qrel) p1[r] = 0.f; } }
                f32x2 s2 = {0.f, 0.f};
#pragma unroll
                for (int i = 0; i < 8; ++i) { s2 += (f32x2){p0[2 * i], p0[2 * i + 1]}; s2 += (f32x2){p1[2 * i], p1[2 * i + 1]}; }
                l1 += s2[0] + s2[1];
#pragma unroll
                for (int i = 0; i < 4; ++i) { pw1[0][i] = cvtpk(p0[2 * i], p0[2 * i + 1]); pw1[1][i] = cvtpk(p0[8 + 2 * i], p0[9 + 2 * i]); pw1[2][i] = cvtpk(p1[2 * i], p1[2 * i + 1]); pw1[3][i] = cvtpk(p1[8 + 2 * i], p1[9 + 2 * i]); }
            } else {
                const bool farT = (k0 <= qw - 154);
#pragma unroll
                for (int mp = 0; mp < 2; ++mp) {
                    f32x16 p0, p1;
#pragma unroll
                    for (int dd = 0; dd < 2; ++dd) { const int d0 = 2 * mp + dd; const bf16x8 k0f = *(const LAS bf16x8*)(kp + d0 * 2048), k1f = *(const LAS bf16x8*)(kp + d0 * 2048 + 512);
                        p0 = __builtin_amdgcn_mfma_f32_32x32x16_bf16(k0f, qr[d0], dd == 0 ? cfv : p0, 0, 0, 0); p1 = __builtin_amdgcn_mfma_f32_32x32x16_bf16(k1f, qr[d0], dd == 0 ? cfv : p1, 0, 0, 0); }
                    if (!farT) { const LAS float* lp = lut + (k0 - qw - r32 + 192 + 4 * hi);
#pragma unroll
                        for (int r = 0; r < 16; ++r) { const int kr = (r & 3) + 8 * (r >> 2); p0[r] += lp[kr]; p1[r] += lp[kr + 32]; } }
                    f32x2 s2 = {0.f, 0.f};
#pragma unroll
                    for (int i = 0; i < 8; ++i) { p0[2 * i] = __builtin_amdgcn_exp2f(p0[2 * i]); p0[2 * i + 1] = __builtin_amdgcn_exp2f(p0[2 * i + 1]); p1[2 * i] = __builtin_amdgcn_exp2f(p1[2 * i]); p1[2 * i + 1] = __builtin_amdgcn_exp2f(p1[2 * i + 1]);
                        s2 += (f32x2){p0[2 * i], p0[2 * i + 1]}; s2 += (f32x2){p1[2 * i], p1[2 * i + 1]}; }
                    const float sa = s2[0] + s2[1];
                    if (mp == 0) { l1 += sa;
#pragma unroll
                        for (int i = 0; i < 4; ++i) { pw1[0][i] = cvtpk(p0[2 * i], p0[2 * i + 1]); pw1[1][i] = cvtpk(p0[8 + 2 * i], p0[9 + 2 * i]); pw1[2][i] = cvtpk(p1[2 * i], p1[2 * i + 1]); pw1[3][i] = cvtpk(p1[8 + 2 * i], p1[9 + 2 * i]); }
                    } else { l2 += sa;
#pragma unroll
                        for (int i = 0; i < 4; ++i) { pw2[0][i] = cvtpk(p0[2 * i], p0[2 * i + 1]); pw2[1][i] = cvtpk(p0[8 + 2 * i], p0[9 + 2 * i]); pw2[2][i] = cvtpk(p1[2 * i], p1[2 * i + 1]); pw2[3][i] = cvtpk(p1[8 + 2 * i], p1[9 + 2 * i]); } }
                }
            }
#pragma unroll
            for (int dh = 0; dh < 2; ++dh)
#pragma unroll
                for (int ks = 0; ks < 4; ++ks) { const s16x4 lo = vtr(vp + dh * 4096 + ks * 1024), hh = vtr(vp + dh * 4096 + ks * 1024 + 512);
                    const bf16x8 vf = (bf16x8){lo[0], lo[1], lo[2], lo[3], hh[0], hh[1], hh[2], hh[3]};
                    o1[dh] = __builtin_amdgcn_mfma_f32_32x32x16_bf16(vf, __builtin_bit_cast(bf16x8, pw1[ks]), o1[dh], 0, 0, 0);
                    if (!FOX) o2[dh] = __builtin_amdgcn_mfma_f32_32x32x16_bf16(vf, __builtin_bit_cast(bf16x8, pw2[ks]), o2[dh], 0, 0, 0); }
        }
        slot = nslot;
    }
    if (tid == 0) *uslot = nxt;
    { auto rr = __builtin_amdgcn_permlane32_swap(__float_as_uint(l1), __float_as_uint(l1), false, false); l1 = __uint_as_float(rr[0]) + __uint_as_float(rr[1]); }
    const float i1 = 1.f / l1;
    if (FOX) {
#pragma unroll
        for (int dh = 0; dh < 2; ++dh)
#pragma unroll
            for (int r = 0; r < 16; ++r) o1[dh][r] *= i1;
    } else {
        { auto rr = __builtin_amdgcn_permlane32_swap(__float_as_uint(l2), __float_as_uint(l2), false, false); l2 = __uint_as_float(rr[0]) + __uint_as_float(rr[1]); }
        const float i2 = sb[64] / l2; float ss = 0.f;
#pragma unroll
        for (int dh = 0; dh < 2; ++dh)
#pragma unroll
            for (int r = 0; r < 16; ++r) { const float v = o1[dh][r] * i1 - o2[dh][r] * i2; o1[dh][r] = v; ss += v * v; }
        { auto rr = __builtin_amdgcn_permlane32_swap(__float_as_uint(ss), __float_as_uint(ss), false, false); ss = __uint_as_float(rr[0]) + __uint_as_float(rr[1]); }
        const float rn = __builtin_amdgcn_rsqf(ss * (1.f / 64) + 1e-6f) * 0.8f;
#pragma unroll
        for (int dh = 0; dh < 2; ++dh)
#pragma unroll
            for (int g = 0; g < 4; ++g) { const f32x4 gs = *(const LAS f32x4*)(sb + 32 * dh + 8 * g + 4 * hi);
#pragma unroll
                for (int e = 0; e < 4; ++e) o1[dh][4 * g + e] *= rn * gs[e]; }
    }
    LAS char* ost = shm + L_OST + wid * (32 * OST_ROW);
#pragma unroll
    for (int dh = 0; dh < 2; ++dh)
#pragma unroll
        for (int g = 0; g < 4; ++g) { int w = 0; w = __builtin_amdgcn_cvt_pk_fp8_f32(o1[dh][4 * g], o1[dh][4 * g + 1], w, false); w = __builtin_amdgcn_cvt_pk_fp8_f32(o1[dh][4 * g + 2], o1[dh][4 * g + 3], w, true);
            *(LAS unsigned*)(ost + r32 * OST_ROW + (32 * dh + 8 * g + 4 * hi)) = (unsigned)w; }
    asm volatile("s_waitcnt lgkmcnt(0)" ::: "memory");
    unsigned char* Ow = (unsigned char*)T.O + ((size_t)b * SEQ + qw) * DM + (FOX ? 0 : 512) + h * 64;
#pragma unroll
    for (int i = 0; i < 2; ++i) { const int row = i * 16 + (lane >> 2), ch = lane & 3; const u32x4 v = *(const LAS u32x4*)(ost + row * OST_ROW + ch * 16); *(u32x4*)(Ow + (size_t)row * DM + ch * 16) = v; }
    asm volatile("s_waitcnt lgkmcnt(0)\n\ts_barrier" ::: "memory");
#undef ATT_DMA
}
__device__ __forceinline__ void attn_phase(const Tensors& T, LAS char* shm) {
    const int tid = tid_opaque(); volatile LAS int* uslot = (volatile LAS int*)(shm + L_END);
    { LAS float* sbp = (LAS float*)(shm + L_SB); if (tid < 64) sbp[tid] = T.gsub[tid]; if (tid == 64) sbp[64] = T.consts[9]; }
    if (tid == 0) *uslot = (int)__hip_atomic_fetch_add(T.qctr, 1u, __ATOMIC_RELAXED, __HIP_MEMORY_SCOPE_AGENT);
    asm volatile("s_waitcnt vmcnt(0) lgkmcnt(0)\n\ts_barrier" ::: "memory");
    int u = __builtin_amdgcn_readfirstlane(*uslot);
    while (u < 2048) {
        int nxt = 0; if (tid == 0) nxt = (int)__hip_atomic_fetch_add(T.qctr, 1u, __ATOMIC_RELAXED, __HIP_MEMORY_SCOPE_AGENT);
        const int r = u & 1023, qb = 15 - (r >> 6), bh = r & 63;
        if (u < 1024) attn_unit<false>(bh, qb, T, shm, uslot, nxt); else attn_unit<true>(bh, qb, T, shm, uslot, nxt);
        u = __builtin_amdgcn_readfirstlane(*uslot);
    }
}
#undef ATT_WAIT_BAR
}

namespace peers {
typedef unsigned u32x4 __attribute__((ext_vector_type(4)));
typedef unsigned u32x2 __attribute__((ext_vector_type(2)));
typedef float f32x4 __attribute__((ext_vector_type(4)));
typedef float f2_t __attribute__((ext_vector_type(2)));
template <int CTRL> __device__ __forceinline__ float dpp(float x) { return __builtin_bit_cast(float, __builtin_amdgcn_mov_dpp(__builtin_bit_cast(int, x), CTRL, 0xf, 0xf, true)); }
__device__ __forceinline__ float gelu_as(float v) {
    const float av = fabsf(v), t = __builtin_amdgcn_rcpf(av * 0.2316418882f + 1.0f);
    float q = t * 0.5307027145f + (-0.7265760135f); q = q * t + 0.7107068705f; q = q * t + (-0.142248368f); q = q * t + 0.127414796f; q = q * t;
    const float e = __builtin_amdgcn_exp2f(v * v * (-0.72134752044f)), m = v * (q * e);
    return v < 0.f ? m : v - m;
}
struct SArgs { float* H; const bf16* xb; const float* rowpart; const int* idx; const float* gw; const unsigned char* T8in; const unsigned char* T8out; const float* sin_; const float* sout_;
               const float* plen; bf16* xn2; float* zpart; float* act; float* r2part; const unsigned char* x8; const float* sx; unsigned short* actq; float* sact; const float* rstdv; float* ssum; unsigned char* h8; };
__device__ __forceinline__ void gx_phase(const bf16* xb, unsigned char* xq, float* sx, const float* rowpart, float* rstdv) {
    const int tid = tid_opaque(), lane = tid & 63, wave = tid >> 6; const int S = gridDim.x * 8; constexpr int GX_NQ = 4;
#pragma unroll 1
    for (int tb = blockIdx.x * 8 + wave; tb < TOK; tb += GX_NQ * S) {
        u32x4 wv[GX_NQ][2]; float rp[GX_NQ];
#pragma unroll
        for (int q = 0; q < GX_NQ; ++q) { const int t = tb + q * S; if (t < TOK) { wv[q][0] = *(const u32x4*)(xb + (size_t)t * DM + lane * 16); wv[q][1] = *(const u32x4*)(xb + (size_t)t * DM + lane * 16 + 8); rp[q] = rowpart[(size_t)t * 16 + (lane & 15)]; } }
#pragma unroll
        for (int q = 0; q < GX_NQ; ++q) { const int t = tb + q * S; if (t < TOK) {
            float xf[16];
#pragma unroll
            for (int hlf = 0; hlf < 2; ++hlf) { const u32x4 w = wv[q][hlf];
                xf[hlf * 8 + 0] = __builtin_bit_cast(float, w.x << 16); xf[hlf * 8 + 1] = __builtin_bit_cast(float, w.x & 0xffff0000u); xf[hlf * 8 + 2] = __builtin_bit_cast(float, w.y << 16); xf[hlf * 8 + 3] = __builtin_bit_cast(float, w.y & 0xffff0000u);
                xf[hlf * 8 + 4] = __builtin_bit_cast(float, w.z << 16); xf[hlf * 8 + 5] = __builtin_bit_cast(float, w.z & 0xffff0000u); xf[hlf * 8 + 6] = __builtin_bit_cast(float, w.w << 16); xf[hlf * 8 + 7] = __builtin_bit_cast(float, w.w & 0xffff0000u); }
            float mx = 0.f;
#pragma unroll
            for (int k = 0; k < 16; ++k) mx = fmaxf(mx, fabsf(xf[k]));
            mx = fmaxf(mx, dpp<0xB1>(mx)); mx = fmaxf(mx, dpp<0x4E>(mx)); mx = fmaxf(mx, dpp<0x141>(mx)); mx = fmaxf(mx, dpp<0x140>(mx));
            const float sc = mx > 0.f ? mx * (1.f / 119.f) : 1.f, inv = 1.f / sc; unsigned xh[2] = {0u, 0u}, xl[2] = {0u, 0u};
#pragma unroll
            for (int k = 0; k < 16; ++k) { int xi = __float2int_rn(xf[k] * inv); xi = xi < -120 ? -120 : (xi > 119 ? 119 : xi); const int lo = ((xi + 8) & 15) - 8, hi = (xi - lo) >> 4;
                xh[k >> 3] |= (unsigned)(hi & 15) << (4 * (k & 7)); xl[k >> 3] |= (unsigned)(lo & 15) << (4 * (k & 7)); }
            { unsigned char* blk = xq + (size_t)t * 1024 + (lane >> 1) * 32 + (lane & 1) * 8; u32x2 oh, ol; oh.x = xh[0]; oh.y = xh[1]; ol.x = xl[0]; ol.y = xl[1];
              *(u32x2*)blk = oh; *(u32x2*)(blk + 16) = ol; }
            if ((lane & 15) == 0) sx[(size_t)t * 4 + (lane >> 4)] = sc;
            { float sp = rp[q]; sp += dpp<0xB1>(sp); sp += dpp<0x4E>(sp); sp += dpp<0x141>(sp); sp += dpp<0x140>(sp);
              if (lane == 0) rstdv[t] = __builtin_amdgcn_rsqf(sp * (1.f / 1024) + 1e-6f); } } }
    }
}
__device__ __forceinline__ void ga_phase(const SArgs& A, LAS char* shm) {
    const int tid = tid_opaque(), lane = tid & 63, wave = tid >> 6, g8 = lane >> 3, i8 = lane & 7;
    const int s = blockIdx.x & 7, sl = s & 3, half = s >> 2, nw = (gridDim.x >> 3) * 8;
    LAS int* sidx = (LAS int*)(shm + wave * 1024); LAS float* zst = (LAS float*)(sidx + 128);
    const unsigned char* Tb = A.T8in + (size_t)sl * 16384 * 128 + i8 * 16;
    const unsigned char* xq = A.x8 + sl * 256 + i8 * 32;
    u32x4 rbA[16], rbB[16], xhA, xlA, xhB, xlB; float sxA, sxB; int ia, ib;
#define GA_FETCH(tt) do { ia = A.idx[(size_t)(tt) * 128 + lane]; ib = A.idx[(size_t)(tt) * 128 + 64 + lane]; } while (0)
#define GA_ISSUE(RB, XH, XL, SX, tt) do { sidx[lane] = ia; sidx[lane + 64] = ib; XH = *(const u32x4*)(xq + (size_t)(tt) * 1024); XL = *(const u32x4*)(xq + (size_t)(tt) * 1024 + 16); SX = A.sx[(size_t)(tt) * 4 + sl]; \
        _Pragma("unroll") for (int r = 0; r < 16; ++r) { const unsigned e = (unsigned)sidx[8 * r + g8]; RB[r] = *(const u32x4*)(Tb + (e << 7)); } } while (0)
#define GA_COMPUTE(RB, XH, XL, SX, tt) do { int k0v = 0, k1v = 0; \
        _Pragma("unroll") for (int r = 0; r < 16; ++r) { int dh = 0, dl = 0; \
            _Pragma("unroll") for (int j = 0; j < 4; ++j) { dh = __builtin_amdgcn_sdot8((int)RB[r][j], (int)XH[j], dh, false); dl = __builtin_amdgcn_sdot8((int)RB[r][j], (int)XL[j], dl, false); } \
            int d = dh * 16 + dl; \
            d += __builtin_amdgcn_mov_dpp(d, 0xB1, 0xf, 0xf, true); d += __builtin_amdgcn_mov_dpp(d, 0x4E, 0xf, 0xf, true); d += __builtin_amdgcn_mov_dpp(d, 0x141, 0xf, 0xf, true); \
            if (r < 8) k0v = (i8 == r) ? d : k0v; else k1v = (i8 == r - 8) ? d : k1v; } \
        const float z0 = (float)k0v * SX, z1 = (float)k1v * SX, p0 = dpp<0x128>(z0), p1 = dpp<0x128>(z1); \
        const unsigned w_ = (g8 & 1) ? pg8::cvt_pk_bf16(p1, z1) : pg8::cvt_pk_bf16(z0, p0); \
        ((unsigned*)A.zpart)[((size_t)sl * TOK + (tt)) * 64 + ((g8 & 1) ? 32 : 0) + 4 * i8 + (g8 >> 1)] = w_; } while (0)
    const int nw2 = 2 * nw;
    int t0 = (blockIdx.x >> 3) * 8 + wave + half * nw;
    if (t0 < TOK) { GA_FETCH(t0); GA_ISSUE(rbA, xhA, xlA, sxA, t0); }
    int t1 = t0 + nw2; if (t1 < TOK) GA_FETCH(t1);
    while (t0 < TOK) {
        const int t2 = t1 + nw2;
        if (t1 < TOK) { GA_ISSUE(rbB, xhB, xlB, sxB, t1); if (t2 < TOK) GA_FETCH(t2); }
        GA_COMPUTE(rbA, xhA, xlA, sxA, t0);
        if (t1 >= TOK) break;
        const int t3 = t2 + nw2;
        if (t2 < TOK) { GA_ISSUE(rbA, xhA, xlA, sxA, t2); if (t3 < TOK) GA_FETCH(t3); }
        GA_COMPUTE(rbB, xhB, xlB, sxB, t1);
        t0 = t2; t1 = t3;
    }
#undef GA_FETCH
#undef GA_ISSUE
#undef GA_COMPUTE
}
__device__ __forceinline__ void gr_phase(const SArgs& A) {
    const int tid = tid_opaque(), lane = tid & 63, wave = tid >> 6; const int S = gridDim.x * 8;
    typedef int i32x2 __attribute__((ext_vector_type(2))); constexpr int GR_NQ = 8;
#pragma unroll 1
    for (int tb = blockIdx.x * 8 + wave; tb < TOK; tb += GR_NQ * S) {
        unsigned zw[GR_NQ][4]; f2_t gv[GR_NQ]; float rs[GR_NQ], si[GR_NQ][2], so[GR_NQ][2]; i32x2 ee[GR_NQ];
#pragma unroll
        for (int q = 0; q < GR_NQ; ++q) { const int t = tb + q * S; if (t < TOK) { rs[q] = A.rstdv[t];
            ee[q] = *(const i32x2*)(A.idx + (size_t)t * 128 + 2 * lane); gv[q] = *(const f2_t*)(A.gw + (size_t)t * 128 + 2 * lane);
#pragma unroll
            for (int s = 0; s < 4; ++s) zw[q][s] = ((const unsigned*)A.zpart)[((size_t)s * TOK + t) * 64 + lane]; } }
#pragma unroll
        for (int q = 0; q < GR_NQ; ++q) { const int t = tb + q * S; if (t < TOK) {
            si[q][0] = A.sin_[ee[q].x]; so[q][0] = A.sout_[ee[q].x]; si[q][1] = A.sin_[ee[q].y]; so[q][1] = A.sout_[ee[q].y]; } }
#pragma unroll
        for (int q = 0; q < GR_NQ; ++q) { const int t = tb + q * S; if (t < TOK) { float z0 = 0.f, z1 = 0.f;
#pragma unroll
            for (int s = 0; s < 4; ++s) { z0 += __builtin_bit_cast(float, zw[q][s] << 16); z1 += __builtin_bit_cast(float, zw[q][s] & 0xffff0000u); }
            const float a0 = gelu_as(z0 * (si[q][0] * rs[q])) * gv[q].x * so[q][0], a1 = gelu_as(z1 * (si[q][1] * rs[q])) * gv[q].y * so[q][1];
            const float mx = wave_max(fmaxf(fabsf(a0), fabsf(a1)));
            const float sa = mx > 0.f ? mx * (1.f / 127.f) : 1.f, inv = 1.f / sa;
            const int q0 = __float2int_rn(a0 * inv), q1 = __float2int_rn(a1 * inv);
            ((unsigned short*)A.actq)[(size_t)t * 64 + lane] = (unsigned short)((q0 & 0xff) | ((q1 & 0xff) << 8));
            { const float sq_ = wave_sum((float)(q0 + q1)); if (lane == 0) A.ssum[t] = sq_; }
            if (lane == 0) A.sact[t] = sa; } }
    }
}
typedef int i32x4m __attribute__((ext_vector_type(4)));
__device__ __forceinline__ void gb_phase(const SArgs& A, LAS char* shm) {
    const int tid = tid_opaque(), lane = tid & 63, wave = tid >> 6, g8 = lane >> 3, i8 = lane & 7, n = lane & 15, kg = lane >> 4;
    const int s = blockIdx.x & 7, sl = s & 3, half = s >> 2, nw = (gridDim.x >> 3) * 8;
    LAS int* sidx = (LAS int*)(shm + wave * 2048); LAS unsigned* sqA = (LAS unsigned*)(sidx + 128); LAS unsigned* sqB = sqA + 128;
    const unsigned char* Tb = A.T8out + (size_t)sl * 16384 * 128 + i8 * 16;
    const unsigned bm = 0xffu << (8u * (n & 3)), m0 = (n >> 2) == 0 ? bm : 0u, m1 = (n >> 2) == 1 ? bm : 0u, m2 = (n >> 2) == 2 ? bm : 0u, m3 = (n >> 2) == 3 ? bm : 0u;
    const int jb = (kg >> 1) * 2, cA = sl * 256 + 32 * (4 * (kg & 1) + jb) + 8 * (n >> 2) + 2 * (n & 3), cB = cA + 32;
    u32x4 rbA[16], rbB[16]; unsigned hA0, hA1, hB0, hB1; float saA, saB, ssA, ssB; int ia, ib; unsigned aqw;
#define GB_FETCH(tt) do { ia = A.idx[(size_t)(tt) * 128 + lane]; ib = A.idx[(size_t)(tt) * 128 + 64 + lane]; aqw = ((const unsigned short*)A.actq)[(size_t)(tt) * 64 + lane]; } while (0)
#define GB_ISSUE(RB, SQ, H0, H1, SA, SS, tt) do { sidx[lane] = ia; sidx[lane + 64] = ib; { u32x2 rep_; rep_.x = (aqw & 0xffu) * 0x01010101u; rep_.y = (aqw >> 8) * 0x01010101u; *(LAS u32x2*)((SQ) + 2 * lane) = rep_; } SA = A.sact[tt]; SS = A.ssum[tt]; \
        H0 = *(const unsigned*)(A.xn2 + (size_t)(tt) * DM + cA); H1 = *(const unsigned*)(A.xn2 + (size_t)(tt) * DM + cB); \
        _Pragma("unroll") for (int r = 0; r < 16; ++r) { const unsigned e = (unsigned)sidx[8 * r + g8]; RB[r] = *(const u32x4*)(Tb + (e << 7)); } } while (0)
#define GB_COMPUTE(RB, SQ, H0, H1, SA, SS, tt) do { i32x4m de1 = {0, 0, 0, 0}, de2 = de1, do1 = de1, do2 = de1; \
        _Pragma("unroll") for (int r = 0; r < 16; ++r) { const u32x2 aq2 = *(const LAS u32x2*)((SQ) + 8 * r + 2 * kg); const unsigned te = aq2.x, to = aq2.y; \
            const i32x4m be = {(int)(te & m0), (int)(te & m1), (int)(te & m2), (int)(te & m3)}, bo = {(int)(to & m0), (int)(to & m1), (int)(to & m2), (int)(to & m3)}; \
            const i32x4m a1 = {(int)(RB[r].x & 0x0F0F0F0Fu), (int)(RB[r].y & 0x0F0F0F0Fu), (int)(RB[r].z & 0x0F0F0F0Fu), (int)(RB[r].w & 0x0F0F0F0Fu)};     \
            const i32x4m a2 = {(int)RB[r].x, (int)RB[r].y, (int)RB[r].z, (int)RB[r].w};     \
            de1 = __builtin_amdgcn_mfma_i32_16x16x64_i8(a1, be, de1, 0, 0, 0); de2 = __builtin_amdgcn_mfma_i32_16x16x64_i8(a2, be, de2, 0, 0, 0); \
            do1 = __builtin_amdgcn_mfma_i32_16x16x64_i8(a1, bo, do1, 0, 0, 0); do2 = __builtin_amdgcn_mfma_i32_16x16x64_i8(a2, bo, do2, 0, 0, 0); } \
        int v1[4], v2[4]; \
        _Pragma("unroll") for (int j = 0; j < 4; ++j) { const int x1 = kg < 2 ? de1[j] : do1[j], x2 = kg < 2 ? de2[j] : do2[j]; \
            { auto rr = __builtin_amdgcn_permlane32_swap((unsigned)x1, (unsigned)x1, false, false); v1[j] = (int)rr[0] + (int)rr[1]; } \
            { auto rr = __builtin_amdgcn_permlane32_swap((unsigned)x2, (unsigned)x2, false, false); v2[j] = (int)rr[0] + (int)rr[1]; } } \
        const float sc_ = SA * (1.f / 16.f), off_ = 8.f * SS; \
        const float oA0 = ((float)(kg < 2 ? v1[0] : v1[2]) - off_) * SA, oA1 = (float)(kg < 2 ? v2[0] - v1[0] : v2[2] - v1[2]) * sc_, oB0 = ((float)(kg < 2 ? v1[1] : v1[3]) - off_) * SA, oB1 = (float)(kg < 2 ? v2[1] - v1[1] : v2[3] - v1[3]) * sc_; \
        const float nA0 = __builtin_bit_cast(float, H0 << 16) + oA0, nA1 = __builtin_bit_cast(float, H0 & 0xffff0000u) + oA1, nB0 = __builtin_bit_cast(float, H1 << 16) + oB0, nB1 = __builtin_bit_cast(float, H1 & 0xffff0000u) + oB1; \
        *(unsigned*)(A.xn2 + (size_t)(tt) * DM + cA) = pg8::cvt_pk_bf16(nA0, nA1); *(unsigned*)(A.xn2 + (size_t)(tt) * DM + cB) = pg8::cvt_pk_bf16(nB0, nB1); \
        { const int p8 = __builtin_amdgcn_cvt_pk_fp8_f32(nB0, nB1, __builtin_amdgcn_cvt_pk_fp8_f32(nA0, nA1, 0, false), true);     \
          *(unsigned short*)(A.h8 + (size_t)(tt) * DM + cA) = (unsigned short)(p8 & 0xffff); *(unsigned short*)(A.h8 + (size_t)(tt) * DM + cB) = (unsigned short)((unsigned)p8 >> 16); } \
        const float ss = wave_sum((nA0 * nA0 + nA1 * nA1) + (nB0 * nB0 + nB1 * nB1)); if (lane == 0) A.r2part[(size_t)(tt) * 4 + sl] = ss; } while (0)
    const int nw2 = 2 * nw;
    int t0 = (blockIdx.x >> 3) * 8 + wave + half * nw;
    if (t0 < TOK) { GB_FETCH(t0); GB_ISSUE(rbA, sqA, hA0, hA1, saA, ssA, t0); }
    int t1 = t0 + nw2; if (t1 < TOK) GB_FETCH(t1);
    while (t0 < TOK) {
        const int t2 = t1 + nw2;
        if (t1 < TOK) { GB_ISSUE(rbB, sqB, hB0, hB1, saB, ssB, t1); if (t2 < TOK) GB_FETCH(t2); }
        GB_COMPUTE(rbA, sqA, hA0, hA1, saA, ssA, t0);
        if (t1 >= TOK) break;
        const int t3 = t2 + nw2;
        if (t2 < TOK) { GB_ISSUE(rbA, sqA, hA0, hA1, saA, ssA, t2); if (t3 < TOK) GB_FETCH(t3); }
        GB_COMPUTE(rbB, sqB, hB0, hB1, saB, ssB, t1);
        t0 = t2; t1 = t3;
    }
#undef GB_FETCH
#undef GB_ISSUE
#undef GB_COMPUTE
}
}

namespace route {
typedef short bf16x8 __attribute__((ext_vector_type(8)));
typedef float f32x16 __attribute__((ext_vector_type(16)));
typedef unsigned u32x4 __attribute__((ext_vector_type(4)));
__device__ __forceinline__ int imax(int a, int b) { int r; asm("v_max_f32 %0, %1, %2" : "=v"(r) : "v"(a), "v"(b)); return r; }
__device__ __forceinline__ int imin(int a, int b) { int r; asm("v_min_f32 %0, %1, %2" : "=v"(r) : "v"(a), "v"(b)); return r; }
__device__ __forceinline__ int f2key(float f) { return __builtin_bit_cast(int, f); }
__device__ __forceinline__ float key2f(int k) { return __builtin_bit_cast(float, k); }
__device__ __forceinline__ void sort16_desc(int (&a)[16]) {
#define RT_CE(i, j) { const int hi_ = imax(a[i], a[j]), lo_ = imin(a[i], a[j]); a[i] = hi_; a[j] = lo_; }
    RT_CE(0, 13) RT_CE(1, 12) RT_CE(2, 15) RT_CE(3, 14) RT_CE(4, 8) RT_CE(5, 6) RT_CE(7, 11) RT_CE(9, 10)
    RT_CE(0, 5) RT_CE(1, 7) RT_CE(2, 9) RT_CE(3, 4) RT_CE(6, 13) RT_CE(8, 14) RT_CE(10, 15) RT_CE(11, 12)
    RT_CE(0, 1) RT_CE(2, 3) RT_CE(4, 5) RT_CE(6, 8) RT_CE(7, 9) RT_CE(10, 11) RT_CE(12, 13) RT_CE(14, 15)
    RT_CE(0, 2) RT_CE(1, 3) RT_CE(4, 10) RT_CE(5, 11) RT_CE(6, 7) RT_CE(8, 9) RT_CE(12, 14) RT_CE(13, 15)
    RT_CE(1, 2) RT_CE(3, 12) RT_CE(4, 6) RT_CE(5, 7) RT_CE(8, 10) RT_CE(9, 11) RT_CE(13, 14)
    RT_CE(1, 4) RT_CE(2, 6) RT_CE(5, 8) RT_CE(7, 10) RT_CE(9, 13) RT_CE(11, 14)
    RT_CE(2, 4) RT_CE(3, 6) RT_CE(9, 12) RT_CE(11, 13)
    RT_CE(3, 5) RT_CE(6, 8) RT_CE(7, 9) RT_CE(10, 12)
    RT_CE(3, 4) RT_CE(5, 6) RT_CE(7, 8) RT_CE(9, 10) RT_CE(11, 12)
    RT_CE(6, 7) RT_CE(8, 9)
#undef RT_CE
}
__device__ __forceinline__ void merge_top16(int (&a)[16], const int (&b)[16]) {
#pragma unroll
    for (int i = 0; i < 16; ++i) a[i] = imax(a[i], b[15 - i]);
#pragma unroll
    for (int j = 8; j > 0; j >>= 1)
#pragma unroll
        for (int i = 0; i < 16; ++i) { const int l = i ^ j; if (l > i) { const int hi = imax(a[i], a[l]), lo = imin(a[i], a[l]); a[i] = hi; a[l] = lo; } }
}
__device__ __forceinline__ void merge_partner(int (&a)[16]) {
    int p[16];
#pragma unroll
    for (int i = 0; i < 16; ++i) p[i] = __shfl_xor(a[i], 32);
    merge_top16(a, p);
}
__device__ constexpr int CA[27] = {0,0,0,0,0,0,0,0,0,0,0,0,0,0,0, 1,1,1,1,1,1, 2,2, 0,1,2,3};
__device__ constexpr int CB[27] = {1,2,3,4,5,6,7,8,9,10,11,12,13,14,15, 2,3,4,5,6,7, 3,4, 0,1,2,3};
struct RArgs { const bf16* q; const bf16* skb; int* idx; float* gw; };
__device__ __forceinline__ void route_phase(const RArgs& A, LAS char* shm) {
    const int tid = tid_opaque(), lane = tid & 63, wave = tid >> 6, r32 = lane & 31, hh = lane >> 5;
    LAS char* wreg = shm + wave * 8704;
    LAS int* tab = (LAS int*)wreg + lane * 33;
    const int h = blockIdx.x & 7, ntg = gridDim.x >> 3;
    LAS char* skl = shm + 8 * 8704;
    u32x4 qs[8]; bool qs_valid = false;
    { const int tile0 = (blockIdx.x >> 3) + ntg * wave;
      if (tile0 < TOK / 32) { qs_valid = true;
#pragma unroll
        for (int j = 0; j < 8; ++j) qs[j] = *(const u32x4*)((const char*)A.q + ((unsigned)(tile0 * 32 + 4 * j + (lane >> 4)) * 4096u + (unsigned)(h * 512 + (lane & 15) * 16))); } }
    { const char* src = (const char*)A.skb + (size_t)h * 65536;
#pragma unroll
      for (int ps = 0; ps < 8; ++ps) { const int ci = ps * 512 + tid; *(LAS u32x4*)(skl + (ci >> 4) * 272 + (ci & 15) * 16) = *(const u32x4*)(src + (size_t)ci * 16); } }
    __syncthreads();
    for (int tile = (blockIdx.x >> 3) + ntg * wave; tile < TOK / 32; tile += ntg * 8) {
        const int tok = tile * 32 + r32;
        const char* q_c = (const char*)A.q; unsigned lpart = (unsigned)(r32 * 256 + hh * 16); asm volatile("" : "+v"(lpart));
        const unsigned qoff = (unsigned)(tile * 32) * 4096u + lpart * 16u - (unsigned)(hh * 16) * 15u + (unsigned)(h * 512);
        int hh_l = hh; asm volatile("" : "+v"(hh_l));
        int top[2][16];
#pragma unroll
        for (int c = 0; c < 2; ++c) {
            bf16x8 qf[8];
            { if (!qs_valid) {
#pragma unroll
                for (int j = 0; j < 8; ++j) qs[j] = *(const u32x4*)(q_c + ((unsigned)(tile * 32 + 4 * j + (lane >> 4)) * 4096u + (unsigned)(h * 512 + c * 256 + (lane & 15) * 16))); }
#pragma unroll
              for (int j = 0; j < 8; ++j) *(LAS u32x4*)(wreg + (4 * j + (lane >> 4)) * 272 + (lane & 15) * 16) = qs[j];
              const int ntile = c == 0 ? tile : tile + ntg * 8, nc = c ^ 1; qs_valid = ntile < TOK / 32;
              if (qs_valid) {
#pragma unroll
                for (int j = 0; j < 8; ++j) qs[j] = *(const u32x4*)(q_c + ((unsigned)(ntile * 32 + 4 * j + (lane >> 4)) * 4096u + (unsigned)(h * 512 + nc * 256 + (lane & 15) * 16))); } }
#pragma unroll
            for (int ks = 0; ks < 8; ++ks) qf[ks] = *(const LAS bf16x8*)(wreg + r32 * 272 + ks * 32 + hh * 16);
            int kk[4][16];
#pragma unroll
            for (int kb = 0; kb < 4; ++kb) { f32x16 acc = f32x16{};
                const LAS char* sp = skl + (c * 128 + kb * 32 + r32) * 272 + hh * 16;
#pragma unroll
                for (int ks = 0; ks < 8; ++ks) acc = __builtin_amdgcn_mfma_f32_32x32x16_bf16(*(const LAS bf16x8*)(sp + ks * 32), qf[ks], acc, 0, 0, 0);
#pragma unroll
                for (int r = 0; r < 16; ++r) kk[kb][r] = (f2key(acc[r]) & ~127) | (kb * 32 + (r & 3) + 8 * (r >> 2)); }
#pragma unroll
            for (int kb = 0; kb < 4; ++kb) sort16_desc(kk[kb]);
            merge_top16(kk[0], kk[1]); merge_top16(kk[2], kk[3]); merge_top16(kk[0], kk[2]);
#pragma unroll
            for (int i = 0; i < 16; ++i) kk[0][i] |= hh << 2;
            merge_partner(kk[0]);
#pragma unroll
            for (int i = 0; i < 16; ++i) top[c][i] = kk[0][i];
        }
#pragma unroll
        for (int i = 0; i < 16; ++i) { tab[i] = top[0][i] & 127; tab[16 + i] = top[1][i] & 127; }
        float s0[16], s1[16];
#pragma unroll
        for (int i = 0; i < 16; ++i) { const float a = key2f(top[0][i] & ~127), b = key2f(top[1][i] & ~127); s0[i] = hh ? b : a; s1[i] = hh ? a : b; }
        int c0[16], c1[16];
#pragma unroll
        for (int k = 0; k < 32; ++k) { int key;
            if (k < 27) { const float sum = s0[CA[k]] + s1[CB[k]]; const int code0 = (CA[k] << 4) | CB[k], code1 = (CB[k] << 4) | CA[k];
                key = (f2key(sum) & ~255) | (hh_l ? code1 : code0); if (k >= 23 && hh_l) key = (int)0xff800000  ; }
            else key = (int)0xff800000  ;
            if (k < 16) c0[k] = key; else c1[k - 16] = key; }
        sort16_desc(c0); sort16_desc(c1); merge_top16(c0, c1); merge_partner(c0);
        float e[16]; const float m = key2f(c0[0] & ~255); float sum = 0.f;
#pragma unroll
        for (int k = 0; k < 16; ++k) { e[k] = __expf(key2f(c0[k] & ~255) - m); sum += e[k]; }
        const float inv = 1.f / sum; unsigned ov[16];
#pragma unroll
        for (int k = 0; k < 16; ++k) { const int a = (c0[k] >> 4) & 15, b = c0[k] & 15; const int ex = tab[a] * 128 + tab[16 + b]; ov[k] = hh ? __float_as_uint(e[k] * inv) : (unsigned)ex; }
        unsigned* dst = hh ? (unsigned*)(A.gw + (size_t)tok * 128 + h * 16) : (unsigned*)(A.idx + (size_t)tok * 128 + h * 16);
#pragma unroll
        for (int k = 0; k < 4; ++k) { u32x4 w; w.x = ov[4 * k]; w.y = ov[4 * k + 1]; w.z = ov[4 * k + 2]; w.w = ov[4 * k + 3]; ((u32x4*)dst)[k] = w; }
    }
}
}
#define XB_TMO      128
#define XB_XCNT(j)  (256  + 64 * (j))
#define XB_XSUB(j)  (1280 + 64 * (j))
#define XB_XGEN(j)  (2304 + 64 * (j))
#define XB_TOP      3328
#define XB_TOPGEN   3392
#define XCD_BAR_WORDS 3456
#define XB_SPIN_CAP (1u << 18)

__device__ __forceinline__ unsigned xb_ld(unsigned* p)              { return __hip_atomic_load(p, __ATOMIC_RELAXED, __HIP_MEMORY_SCOPE_AGENT); }
__device__ __forceinline__ unsigned xb_add(unsigned* p, unsigned v) { return __hip_atomic_fetch_add(p, v, __ATOMIC_RELAXED, __HIP_MEMORY_SCOPE_AGENT); }
__device__ __forceinline__ unsigned xb_xcc_id() { return (unsigned)__builtin_amdgcn_s_getreg((3 << 11) | 20) & 0xFu; }
#define XB_SPIN(cond, bar) do { unsigned _sp = 0; while (cond) { __builtin_amdgcn_s_sleep(1); \
    if ((++_sp & 255u) == 0u) { if (xb_ld(&(bar)[XB_TMO])) break; if (_sp > XB_SPIN_CAP) { atomicAdd(&(bar)[XB_TMO], 1u); break; } } } } while (0)

struct XcdBarrier {
    unsigned* bar; unsigned x;
    volatile LAS unsigned* st;
};

__device__ __forceinline__ XcdBarrier xcd_barrier_post(unsigned* bar, volatile LAS unsigned* st) {
    XcdBarrier b; b.bar = bar; b.x = xb_xcc_id(); b.st = st;
    if (threadIdx.x == 0) (void)xb_add(&bar[XB_XCNT(b.x)], 1u);
    return b;
}
__device__ __forceinline__ void xcd_barrier_complete(unsigned* bar, unsigned x, unsigned& nloc, unsigned& nx) {
    const unsigned G = gridDim.x * gridDim.y * gridDim.z;
    unsigned sum, cnt, mine, sp = 0u;
    for (;;) {
        sum = 0u; cnt = 0u; mine = 0u;
#pragma unroll
        for (unsigned j = 0; j < 16; ++j) { const unsigned c = xb_ld(&bar[XB_XCNT(j)]); sum += c; cnt += (c > 0u) ? 1u : 0u; mine = (j == x) ? c : mine; }
        if (sum == G) break;
        __builtin_amdgcn_s_sleep(1);
        if ((++sp & 255u) == 0u) { if (xb_ld(&bar[XB_TMO])) break; if (sp > XB_SPIN_CAP) { atomicAdd(&bar[XB_TMO], 1u); break; } }
    }
    nloc = mine > 0u ? mine : 1u; nx = cnt > 0u ? cnt : 1u;
}

__device__ __forceinline__ void xcd_barrier(const XcdBarrier& b) {
    asm volatile("s_waitcnt vmcnt(0)" ::: "memory");
    __syncthreads();
    if (threadIdx.x == 0) {
        unsigned* bar = b.bar;
        __builtin_amdgcn_s_waitcnt(0);
        unsigned nloc = b.st[0], nx = b.st[1];
        if (nloc == 0u) { xcd_barrier_complete(bar, b.x, nloc, nx); b.st[0] = nloc; b.st[1] = nx; }
        const unsigned old = xb_add(&bar[XB_XSUB(b.x)], 1u);
        const unsigned gen = old / nloc;
        if (old + 1u == (gen + 1u) * nloc) {
            __builtin_amdgcn_fence(__ATOMIC_RELEASE, "agent");
            asm volatile("s_waitcnt vmcnt(0)" ::: "memory");
            __hip_atomic_fetch_add(&bar[XB_TOPGEN], 1u, __ATOMIC_RELAXED, __HIP_MEMORY_SCOPE_AGENT);
        }
        __builtin_amdgcn_fence(__ATOMIC_ACQUIRE, "agent");
        { const unsigned tgt = (gen + 1u) * nx; XB_SPIN(xb_ld(&bar[XB_TOPGEN]) < tgt, bar); }
        asm volatile("s_waitcnt vmcnt(0)" ::: "memory");
    }
    __syncthreads();
}

__device__ __forceinline__ void xcd_arrive(const XcdBarrier& b) {
    asm volatile("s_waitcnt vmcnt(0)" ::: "memory");
    __syncthreads();
    if (threadIdx.x == 0) {
        unsigned* bar = b.bar;
        __builtin_amdgcn_s_waitcnt(0);
        unsigned nloc = b.st[0], nx = b.st[1];
        if (nloc == 0u) { xcd_barrier_complete(bar, b.x, nloc, nx); b.st[0] = nloc; b.st[1] = nx; }
        const unsigned old = xb_add(&bar[XB_XSUB(b.x)], 1u);
        const unsigned gen = old / nloc;
        if (old + 1u == (gen + 1u) * nloc) {
            __builtin_amdgcn_fence(__ATOMIC_RELEASE, "agent");
            asm volatile("s_waitcnt vmcnt(0)" ::: "memory");
            __hip_atomic_fetch_add(&bar[XB_TOPGEN], 1u, __ATOMIC_RELAXED, __HIP_MEMORY_SCOPE_AGENT);
        }
        __builtin_amdgcn_fence(__ATOMIC_ACQUIRE, "agent");
        asm volatile("s_waitcnt vmcnt(0)" ::: "memory");
        b.st[2] = (gen + 1u) * nx;
    }
}
__device__ __forceinline__ void xcd_wait(const XcdBarrier& b) {
    asm volatile("s_waitcnt vmcnt(0)" ::: "memory");
    if (threadIdx.x == 0) { unsigned* bar = b.bar; const unsigned tgt = b.st[2]; XB_SPIN(xb_ld(&bar[XB_TOPGEN]) < tgt, bar); }
    __syncthreads();
}

namespace cg = cooperative_groups;
constexpr int LDS_BYTES = 147456;
constexpr size_t WS_CTL = 6 * MiB + 512 * 1024, WS_IMG = 80 * MiB, WS_SKB = 15 * MiB + 512 * 1024, WS_PBF2 = 272 * MiB;
struct Params { const float* in[24]; float* out; unsigned char* ws; long never; };
__global__ void __launch_bounds__(512, 2) mega(Params P) {
    extern __shared__ __attribute__((aligned(16))) unsigned char lds[];
    const float* x = P.in[0]; const float* p = P.in[1]; const float* mix_norm = P.in[2]; const float* w_in = P.in[3];
    const float* b_f = P.in[4]; const float* gfq = P.in[5]; const float* gfk = P.in[6]; const float* gdq = P.in[7]; const float* gdk = P.in[8];
    const float* lq1 = P.in[9]; const float* lk1 = P.in[10]; const float* lq2 = P.in[11]; const float* lk2 = P.in[12];
    const float* gsub = P.in[13]; const float* table = P.in[14]; const float* w_out = P.in[15]; const float* peer_norm = P.in[16];
    const float* w_query = P.in[17]; const float* sub_keys = P.in[18]; const float* e_in = P.in[19]; const float* e_out = P.in[20];
    const float* ple_norm = P.in[21]; const float* w_gate = P.in[22]; const float* w_ple = P.in[23];
    unsigned char* ws = P.ws; float* out = P.out;
    bf16* wt_in = (bf16*)(ws + WS_WT_IN); bf16* wt_out = (bf16*)(ws + WS_WT_OUT); bf16* wt_q = (bf16*)(ws + WS_WT_Q); bf16* wt_gate = (bf16*)(ws + WS_WT_GATE); bf16* wt_ple = (bf16*)(ws + WS_WT_PLE);
    bf16* xn = (bf16*)(ws + WS_XN); bf16* proj = (bf16*)(ws + WS_PROJ); bf16* O = (bf16*)(ws + WS_O); float* gate = (float*)(ws + WS_GATE); bf16* qkv = (bf16*)(ws + WS_QKV);
    bf16* qb = (bf16*)(ws + WS_Q); float* ple = (float*)(ws + WS_PLE); bf16* pbf = (bf16*)(ws + WS_PBF); int* idx = (int*)(ws + WS_IDX); float* gw = (float*)(ws + WS_G);
    float* logf = out;
    PG8_LAS unsigned char* l3 = (PG8_LAS unsigned char*)lds;
    unsigned* barw = (unsigned*)(ws + WS_CTL);
    if (threadIdx.x < 16) ((LAS unsigned*)(lds + LDS_BYTES - 64))[threadIdx.x] = 0u;
    __syncthreads();
    XcdBarrier xbar = xcd_barrier_post(barw, (volatile LAS unsigned*)(lds + LDS_BYTES - 64));
#define GRID_BAR() xcd_barrier(xbar)
#define GEMM_PHASE(EPI, A_, Bt_, M_, N_, K_, E_) do { pg8::Gemm g_{A_, Bt_, M_, N_, K_, 0}; pg8::StaticOrder S_; S_.init(M_, N_, (int)gridDim.x, (int)blockIdx.x); \
        pg8::gemm_phase<EPI, pg8::StaticOrder, true, true>(l3, g_, S_, E_); } while (0)
    bf16* img = (bf16*)(ws + WS_IMG); bf16* skb = (bf16*)(ws + WS_SKB); float* cloc = out + 2 * 262144; float* ttot = out + 4 * 262144; float* gains = out + 5 * 262144; float* consts = gains + 256;
    pbf = (bf16*)(ws + WS_PBF2); unsigned char* ein8 = ws + 416 * MiB; unsigned char* eout8 = ws + 432 * MiB; float* sc_in = (float*)(ws + 448 * MiB); float* sc_out = sc_in + 16384;
#define MAKE_P0ARGS(name) P0Args name{x, p, mix_norm, w_in, b_f, w_out, w_query, sub_keys, e_in, e_out, w_gate, w_ple, wt_in, wt_out, wt_q, wt_gate, wt_ple, skb, ein8, eout8, sc_in, sc_out, pbf, xn, cloc, ttot, gfq, gfk, gdq, gdk, gains, lq1, lk1, lq2, lk2, table, consts, peer_norm, ple_norm}
    { MAKE_P0ARGS(A);
      ph_p0(A, lds, 1 | 8); }
    xcd_arrive(xbar); { MAKE_P0ARGS(A); ph_p0(A, lds, 16 | 2); } xcd_wait(xbar);
    float* csg = out + 8 * 262144;
    for (int j = blockIdx.x; j < 256; j += gridDim.x) { const int bh = j >> 2, b = bh >> 3, h = bh & 7; float* sbp = (float*)lds;
        __syncthreads();
        if (threadIdx.x < 32) {
            float incl = ttot[(b * 32 + (int)threadIdx.x) * 8 + h];
#pragma unroll
            for (int d = 1; d < 32; d <<= 1) { const float o = __shfl_up(incl, d); if ((int)threadIdx.x >= d) incl += o; }
            float excl = __shfl_up(incl, 1); if (threadIdx.x == 0) excl = 0.f;
            sbp[threadIdx.x] = excl; }
        const int s0 = (j & 3) * 1024 + threadIdx.x;
        const float cl0 = cloc[((size_t)b * SEQ + s0) * 8 + h], cl1 = cloc[((size_t)b * SEQ + s0 + 512) * 8 + h];
        __syncthreads();
        csg[(size_t)bh * SEQ + s0] = -1.4426950408889634f * (sbp[s0 >> 7] + cl0);
        csg[(size_t)bh * SEQ + s0 + 512] = -1.4426950408889634f * (sbp[(s0 + 512) >> 7] + cl1); }
    __syncthreads();
    { pg8::EpiQKV E{img, gains}; GEMM_PHASE(pg8::EpiQKV, xn, wt_in, TOK, 3072, DM, E); }
    xcd_arrive(xbar); { MAKE_P0ARGS(A); ph_p0(A, lds, 4); } xcd_wait(xbar);
    { O = (bf16*)(ws + 288 * MiB); att::Tensors AT{img, O, csg, barw + XCD_BAR_WORDS + 64, consts, table, gsub}; att::attn_phase(AT, (LAS char*)lds); }
    xcd_arrive(xbar); { MAKE_P0ARGS(A); ph_p0(A, lds, 32); } xcd_wait(xbar);
    float* rowpart = (float*)(ws + 80 * MiB); float* r2part = (float*)(ws + 82 * MiB); bf16* ple_b = (bf16*)(ws + 288 * MiB);
    { pg8::EpiResNorm E{x, xn, rowpart}; pg8::Gemm g_{O, wt_out, TOK, DM, DM / 2, 0}; pg8::StaticOrder S_; S_.init(TOK, DM, (int)gridDim.x, (int)blockIdx.x);
      pg8::gemm_phase<pg8::EpiResNorm, pg8::StaticOrder, true, true, true>(l3, g_, S_, E); }
    xcd_arrive(xbar); { MAKE_P0ARGS(A); ph_p0(A, lds, 64); } xcd_wait(xbar);
    { pg8::EpiBf16Row E{qb, rowpart, 2048, 0}; GEMM_PHASE(pg8::EpiBf16Row, xn, wt_q, TOK, 2048, DM, E); }
    unsigned char* x8 = ws + 112 * MiB; float* sxq = (float*)(ws + 84 * MiB); float* rstdv = (float*)(ws + 87 * MiB);
    xcd_arrive(xbar); peers::gx_phase(xn, x8, sxq, rowpart, rstdv); xcd_wait(xbar);
    { route::RArgs RA{qb, skb, idx, gw}; route::route_phase(RA, (LAS char*)lds); }
    GRID_BAR();
    { float* zpart = (float*)(ws + 288 * MiB); float* actb = (float*)(ws + 96 * MiB);
      peers::SArgs SA{out, xn, rowpart, idx, gw, ein8, eout8, sc_in, sc_out, ple_norm, xn, zpart, actb, r2part, x8, sxq, (unsigned short*)actb, (float*)(ws + 86 * MiB), rstdv, (float*)(ws + 86 * MiB + 512 * 1024), ws + 144 * MiB};
      peers::ga_phase(SA, (LAS char*)lds);
      GRID_BAR();
      peers::gr_phase(SA);
      GRID_BAR();
      peers::gb_phase(SA, (LAS char*)lds); }
    xcd_arrive(xbar);
    { pg8::EpiBf16P E{ple_b, DM, 0}; GEMM_PHASE(pg8::EpiBf16P, pbf, wt_ple, TOK, DM, 256, E); }
    xcd_wait(xbar);
    { pg8::EpiGate E{out, xn, ple_b, r2part}; pg8::Gemm g_{(const bf16*)(ws + 144 * MiB), wt_gate, TOK, DM, DM / 2, 0}; pg8::StaticOrder S_; S_.init(TOK, DM, (int)gridDim.x, (int)blockIdx.x);
      pg8::gemm_phase<pg8::EpiGate, pg8::StaticOrder, true, true, true>(l3, g_, S_, E); }
}

extern "C" void kernel_launch(void* const* d_in, const int* in_sizes, int n_in, void* d_out, int out_size, void* d_ws, size_t ws_size, hipStream_t stream) {
    static int grid = 0;
    if (grid == 0) {
        if (n_in != 24 || ws_size < WS_END) { fprintf(stderr, "kernel_launch: unexpected n_in %d / ws %zu\n", n_in, ws_size); grid = -1; return; }
        int dev = 0, cus = 0, per_cu = 0;
        (void)hipGetDevice(&dev); (void)hipDeviceGetAttribute(&cus, hipDeviceAttributeMultiprocessorCount, dev);
        if (hipFuncSetAttribute((const void*)mega, hipFuncAttributeMaxDynamicSharedMemorySize, LDS_BYTES) != hipSuccess) { fprintf(stderr, "kernel_launch: hipFuncSetAttribute failed\n"); grid = -1; return; }
        if (hipOccupancyMaxActiveBlocksPerMultiprocessor(&per_cu, (const void*)mega, 512, LDS_BYTES) != hipSuccess || per_cu < 1) { fprintf(stderr, "kernel_launch: occupancy query failed (%d)\n", per_cu); grid = -1; return; }
        grid = cus * per_cu;
        fprintf(stderr, "kernel_launch: cus %d per_cu %d grid %d\n", cus, per_cu, grid);
    }
    if (grid < 0) return;
    Params P{};
    for (int i = 0; i < 24; ++i) P.in[i] = (const float*)d_in[i];
    P.out = (float*)d_out; P.ws = (unsigned char*)d_ws;
    (void)hipMemsetAsync((unsigned char*)d_ws + WS_CTL, 0, (XCD_BAR_WORDS + 128) * sizeof(unsigned), stream);
    void* args[] = {&P};
    hipError_t e = hipLaunchCooperativeKernel((const void*)mega, dim3(grid), dim3(512), args, LDS_BYTES, stream);
    if (e != hipSuccess) fprintf(stderr, "kernel_launch: cooperative launch failed: %s (grid %d)\n", hipGetErrorString(e), grid);
}
```
